# Optimizing an MI355X kernel written in HIP

```python
import math
import jax, jax.numpy as jnp
from jax import lax
import numpy as np

D_MODEL = 4096
BATCH = 1
SEQ = 8192
DEPTH = 1

CHUNK = 64
MIX_WIDTH = D_MODEL
SSM_WIDTH = MIX_WIDTH // 2
SSM_GROUP = 16
SSM_GROUPS = SSM_WIDTH // SSM_GROUP
SSM_STATE = 64
ATT_QK_DIM = 128
ATT_V_DIM = 2 * ATT_QK_DIM
ATT_WIDTH = MIX_WIDTH - SSM_WIDTH
ATT_HEADS = ATT_WIDTH // ATT_V_DIM
QK_WIDTH = ATT_HEADS * 2 * ATT_QK_DIM
IN_WIDTH = SSM_WIDTH + 2 * QK_WIDTH + ATT_WIDTH
D_FF = ((8 * D_MODEL // 3 + 255) // 256) * 256
CONV_WIDTH = 3
REL_BUCKETS = 32
REL_MAX_DIST = 128
Q_BLOCK = 128
ALPHA = (2 * DEPTH) ** 0.25
BETA = (8 * DEPTH) ** -0.25
LN_EPS = 1e-5
NEG_INF = -1e30

kernel_name = 'hybrid_s5_diffattn_convffn_deepnorm'


def layer_norm(x, g, b):
    xf = x.astype(jnp.float32)
    mu = jnp.mean(xf, axis=-1, keepdims=True)
    xc = xf - mu
    var = jnp.mean(xc * xc, axis=-1, keepdims=True)
    return (xc * lax.rsqrt(var + LN_EPS) * g.astype(jnp.float32) + b.astype(jnp.float32)).astype(x.dtype)


def ssm_mixer(u, log_step, lam_re, lam_im, b_re, b_im, c_re, c_im, d_skip, w_glu, b_glu):
    f32 = jnp.float32
    bsz, seq, _ = u.shape
    ug = u.reshape(bsz, seq, SSM_GROUPS, SSM_GROUP).astype(f32)
    step = jnp.exp(log_step.astype(f32))[:, None]
    lr = lam_re.astype(f32)
    li = lam_im.astype(f32)
    mag = jnp.exp(lr * step)
    ab_re = mag * jnp.cos(li * step)
    ab_im = mag * jnp.sin(li * step)
    den = lr * lr + li * li
    nr = ab_re - 1.0
    ni = ab_im
    z_re = (nr * lr + ni * li) / den
    z_im = (ni * lr - nr * li) / den
    br = b_re.astype(f32)
    bi = b_im.astype(f32)
    bb_re = z_re[..., None] * br - z_im[..., None] * bi
    bb_im = z_re[..., None] * bi + z_im[..., None] * br
    bu_re = jnp.einsum('bsgh,gnh->bsgn', ug, bb_re)
    bu_im = jnp.einsum('bsgh,gnh->bsgn', ug, bb_im)
    a_re = jnp.broadcast_to(ab_re, bu_re.shape)
    a_im = jnp.broadcast_to(ab_im, bu_im.shape)

    def combine(e1, e2):
        a1r, a1i, b1r, b1i = e1
        a2r, a2i, b2r, b2i = e2
        return (a2r * a1r - a2i * a1i,
                a2r * a1i + a2i * a1r,
                a2r * b1r - a2i * b1i + b2r,
                a2r * b1i + a2i * b1r + b2i)

    _, _, h_re, h_im = lax.associative_scan(combine, (a_re, a_im, bu_re, bu_im), axis=1)
    y = (jnp.einsum('ghn,bsgn->bsgh', c_re.astype(f32), h_re)
         - jnp.einsum('ghn,bsgn->bsgh', c_im.astype(f32), h_im))
    y = y + d_skip.astype(f32).reshape(SSM_GROUPS, SSM_GROUP) * ug
    y = jax.nn.gelu(y.reshape(bsz, seq, SSM_WIDTH).astype(u.dtype))
    return y * jax.nn.sigmoid(y @ w_glu + b_glu)


def t5_bucket(rel):
    half = REL_BUCKETS // 2
    max_exact = half // 2
    ret = jnp.where(rel > 0, half, 0)
    n = jnp.abs(rel)
    nf = jnp.maximum(n, 1).astype(jnp.float32)
    large = max_exact + (jnp.log(nf / max_exact) / math.log(REL_MAX_DIST / max_exact)
                         * (half - max_exact)).astype(jnp.int32)
    large = jnp.minimum(large, half - 1)
    return ret + jnp.where(n < max_exact, n, large)


def diff_attention(q, k, v, rel_bias, lam_q1, lam_k1, lam_q2, lam_k2, subln_g, lambda_init):
    f32 = jnp.float32
    bsz, seq = q.shape[0], q.shape[1]
    nb = seq // Q_BLOCK
    scale = ATT_QK_DIM ** -0.5
    lam = (jnp.exp(jnp.sum(lam_q1.astype(f32) * lam_k1.astype(f32)))
           - jnp.exp(jnp.sum(lam_q2.astype(f32) * lam_k2.astype(f32))) + lambda_init)
    kt = k.transpose(0, 2, 3, 1, 4)
    vt = v.transpose(0, 2, 1, 3)
    qb = (q * scale).reshape(bsz, nb, Q_BLOCK, ATT_HEADS, 2, ATT_QK_DIM).transpose(1, 0, 3, 4, 2, 5)
    kpos = jnp.arange(seq)

    def block(args):
        qblk, bidx = args
        qpos = bidx * Q_BLOCK + jnp.arange(Q_BLOCK)
        rel = kpos[None, :] - qpos[:, None]
        bias = rel_bias[t5_bucket(rel)].transpose(2, 0, 1).astype(f32)
        visible = (kpos[None, :] // CHUNK) <= (qpos[:, None] // CHUNK)
        s = jnp.einsum('bhcqd,bhckd->bhcqk', qblk, kt).astype(f32) + bias[None, :, None]
        s = jnp.where(visible, s, NEG_INF)
        p = jax.nn.softmax(s, axis=-1)
        attn = p[:, :, 0] - lam * p[:, :, 1]
        return jnp.einsum('bhqk,bhkd->bhqd', attn.astype(v.dtype), vt)

    o = lax.map(block, (qb, jnp.arange(nb)))
    o = o.transpose(1, 0, 3, 2, 4).reshape(bsz, seq, ATT_HEADS, ATT_V_DIM).astype(f32)
    o = o * lax.rsqrt(jnp.mean(o * o, axis=-1, keepdims=True) + LN_EPS) * subln_g.astype(f32)
    o = o * (1.0 - lambda_init)
    return o.reshape(bsz, seq, ATT_WIDTH).astype(v.dtype)


def conv_ffn(h, w_up, conv_w, conv_b, w_down):
    seq = h.shape[1]
    up = h @ w_up
    a, g = jnp.split(up, 2, axis=-1)
    gp = jnp.pad(g, ((0, 0), (CONV_WIDTH - 1, 0), (0, 0)))
    gc = conv_b
    for j in range(CONV_WIDTH):
        gc = gc + gp[:, j:j + seq] * conv_w[j]
    return (jax.nn.silu(gc) * a) @ w_down


def setup_inputs(seed: int = 0) -> dict:
    key = jax.random.key(seed)
    ks = jax.random.split(key, 32)
    f32 = jnp.float32
    L = DEPTH
    nrm = lambda k, shp, s: jax.random.normal(k, shp, f32) * s
    x = nrm(ks[0], (BATCH, SEQ, D_MODEL), 1.0)
    col_scale = jnp.concatenate([jnp.ones((SSM_WIDTH + 2 * QK_WIDTH,), f32),
                                 jnp.full((ATT_WIDTH,), BETA, f32)])
    w_in = nrm(ks[1], (L, D_MODEL, IN_WIDTH), D_MODEL ** -0.5) * col_scale
    ssm_log_step = jax.random.uniform(ks[2], (L, SSM_GROUPS), f32, math.log(1e-3), math.log(1e-1))
    ssm_lambda_re = -0.5 + nrm(ks[3], (L, SSM_GROUPS, SSM_STATE), 0.01)
    ssm_lambda_im = jnp.broadcast_to(math.pi * jnp.arange(SSM_STATE, dtype=f32), (L, SSM_GROUPS, SSM_STATE)) \
        + nrm(ks[4], (L, SSM_GROUPS, SSM_STATE), 0.01)
    ssm_b_re = nrm(ks[5], (L, SSM_GROUPS, SSM_STATE, SSM_GROUP), (2 * SSM_GROUP) ** -0.5)
    ssm_b_im = nrm(ks[6], (L, SSM_GROUPS, SSM_STATE, SSM_GROUP), (2 * SSM_GROUP) ** -0.5)
    ssm_c_re = nrm(ks[7], (L, SSM_GROUPS, SSM_GROUP, SSM_STATE), (2 * SSM_STATE) ** -0.5)
    ssm_c_im = nrm(ks[8], (L, SSM_GROUPS, SSM_GROUP, SSM_STATE), (2 * SSM_STATE) ** -0.5)
    ssm_d = nrm(ks[9], (L, SSM_WIDTH), 1.0)
    ssm_w_glu = nrm(ks[10], (L, SSM_WIDTH, SSM_WIDTH), SSM_WIDTH ** -0.5)
    ssm_b_glu = nrm(ks[11], (L, SSM_WIDTH), 0.02)
    att_lambda_q1 = nrm(ks[12], (L, ATT_QK_DIM), 0.1)
    att_lambda_k1 = nrm(ks[13], (L, ATT_QK_DIM), 0.1)
    att_lambda_q2 = nrm(ks[14], (L, ATT_QK_DIM), 0.1)
    att_lambda_k2 = nrm(ks[15], (L, ATT_QK_DIM), 0.1)
    att_subln_g = 1.0 + nrm(ks[16], (L, ATT_V_DIM), 0.02)
    rel_bias = nrm(ks[17], (REL_BUCKETS, ATT_HEADS), 0.5)
    w_out = nrm(ks[18], (L, MIX_WIDTH, D_MODEL), MIX_WIDTH ** -0.5 * BETA)
    ln1_g = 1.0 + nrm(ks[19], (L, D_MODEL), 0.02)
    ln1_b = nrm(ks[20], (L, D_MODEL), 0.02)
    ffn_w_up = nrm(ks[21], (L, D_MODEL, 2 * D_FF), D_MODEL ** -0.5)
    ffn_conv_w = nrm(ks[22], (L, CONV_WIDTH, D_FF), CONV_WIDTH ** -0.5)
    ffn_conv_b = nrm(ks[23], (L, D_FF), 0.02)
    ffn_w_down = nrm(ks[24], (L, D_FF, D_MODEL), D_FF ** -0.5 * BETA)
    ln2_g = 1.0 + nrm(ks[25], (L, D_MODEL), 0.02)
    ln2_b = nrm(ks[26], (L, D_MODEL), 0.02)
    return {'x': x, 'w_in': w_in, 'ssm_log_step': ssm_log_step, 'ssm_lambda_re': ssm_lambda_re,
            'ssm_lambda_im': ssm_lambda_im, 'ssm_b_re': ssm_b_re, 'ssm_b_im': ssm_b_im,
            'ssm_c_re': ssm_c_re, 'ssm_c_im': ssm_c_im, 'ssm_d': ssm_d, 'ssm_w_glu': ssm_w_glu,
            'ssm_b_glu': ssm_b_glu, 'att_lambda_q1': att_lambda_q1, 'att_lambda_k1': att_lambda_k1,
            'att_lambda_q2': att_lambda_q2, 'att_lambda_k2': att_lambda_k2, 'att_subln_g': att_subln_g,
            'rel_bias': rel_bias, 'w_out': w_out, 'ln1_g': ln1_g, 'ln1_b': ln1_b,
            'ffn_w_up': ffn_w_up, 'ffn_conv_w': ffn_conv_w, 'ffn_conv_b': ffn_conv_b,
            'ffn_w_down': ffn_w_down, 'ln2_g': ln2_g, 'ln2_b': ln2_b}


def reference(x, w_in, ssm_log_step, ssm_lambda_re, ssm_lambda_im, ssm_b_re, ssm_b_im,
              ssm_c_re, ssm_c_im, ssm_d, ssm_w_glu, ssm_b_glu, att_lambda_q1, att_lambda_k1,
              att_lambda_q2, att_lambda_k2, att_subln_g, rel_bias, w_out, ln1_g, ln1_b,
              ffn_w_up, ffn_conv_w, ffn_conv_b, ffn_w_down, ln2_g, ln2_b):
    h = x
    bsz, seq = x.shape[0], x.shape[1]
    for l in range(DEPTH):
        lambda_init = 0.8 - 0.6 * math.exp(-0.3 * l)
        proj = h @ w_in[l]
        u, q, k, v = jnp.split(proj, [SSM_WIDTH, SSM_WIDTH + QK_WIDTH, SSM_WIDTH + 2 * QK_WIDTH], axis=-1)
        q = q.reshape(bsz, seq, ATT_HEADS, 2, ATT_QK_DIM)
        k = k.reshape(bsz, seq, ATT_HEADS, 2, ATT_QK_DIM)
        v = v.reshape(bsz, seq, ATT_HEADS, ATT_V_DIM)
        y_ssm = ssm_mixer(u, ssm_log_step[l], ssm_lambda_re[l], ssm_lambda_im[l], ssm_b_re[l],
                          ssm_b_im[l], ssm_c_re[l], ssm_c_im[l], ssm_d[l], ssm_w_glu[l], ssm_b_glu[l])
        y_att = diff_attention(q, k, v, rel_bias, att_lambda_q1[l], att_lambda_k1[l],
                               att_lambda_q2[l], att_lambda_k2[l], att_subln_g[l], lambda_init)
        mix = jnp.concatenate([y_ssm, y_att], axis=-1) @ w_out[l]
        h = layer_norm(ALPHA * h + mix, ln1_g[l], ln1_b[l])
        ff = conv_ffn(h, ffn_w_up[l], ffn_conv_w[l], ffn_conv_b[l], ffn_w_down[l])
        h = layer_norm(ALPHA * h + ff, ln2_g[l], ln2_b[l])
    return h
```

```cpp
#include <hip/hip_runtime.h>
#include <hip/hip_cooperative_groups.h>
#include <cstdio>
namespace cg = cooperative_groups;
#include <hip/hip_runtime.h>
namespace pg8 {
#define PG8_LAS __attribute__((address_space(3)))
typedef unsigned short bf16_t;
typedef short bf16x8 __attribute__((ext_vector_type(8)));
typedef float f32x4 __attribute__((ext_vector_type(4)));
typedef unsigned u32x4 __attribute__((ext_vector_type(4)));
constexpr int BM = 256, BK = 64, HALF = 128, HTB = HALF * BK * 2  , STAGE_BYTES = 8 * HTB, NXCD = 8, WGM = 8;

__host__ __device__ __forceinline__ int lds_byte(int r, int c) { const int st = (r >> 4) * 2 + (c >> 5), rr = r & 15, cc = c & 31, ob = rr * 64 + cc * 2; return st * 1024 + (ob ^ (((ob >> 9) & 1) << 5)); }
__host__ __device__ __forceinline__ void stage_rc(int b, int& R, int& C) { const int st = b / 1024, sb = b % 1024, swz = sb ^ (((sb >> 9) & 1) << 5); R = (st >> 1) * 16 + swz / 64; C = (st & 1) * 32 + (swz % 64) / 2; }
__host__ __device__ __forceinline__ int perm32(int rho) { const int n = rho >> 4, i = rho & 15; return 8 * (i >> 2) + 4 * n + (i & 3); }

struct Unit { int pm, pn; };
struct Gemm { const bf16_t* A; const bf16_t* Bt; int M, N, K; };

struct StaticOrder {
    int nM, nN, nwg, G, c;
    __host__ __device__ void init(int M, int N, int G_, int c_) { nM = M / BM; nN = N / BM; nwg = nM * nN; G = G_; c = c_; }
    __host__ __device__ bool next(int i, Unit& u) const {
        const long L = (long)i * G + c; if (L >= nwg) return false;
        int wgid = (int)L; { const int q = nwg / NXCD, r = nwg % NXCD, xcd = wgid % NXCD, off = wgid / NXCD; wgid = (xcd < r ? xcd * (q + 1) : r * (q + 1) + (xcd - r) * q) + off; }
        const int nig = WGM * nN, gid = wgid / nig, fm = gid * WGM, gsz = (nM - fm) < WGM ? (nM - fm) : WGM;
        u.pm = fm + ((wgid % nig) % gsz); u.pn = (wgid % nig) / gsz; return true;
    }
    __device__ __forceinline__ void a_ready(const Unit&) const {}
    __device__ __forceinline__ void done(const Unit&) const {}
};
__device__ __forceinline__ unsigned cvt_pk_bf16(float lo, float hi) { unsigned r; asm volatile("v_cvt_pk_bf16_f32 %0, %1, %2" : "=v"(r) : "v"(lo), "v"(hi)); return r; }
template <class Epi, class Sched, bool ALIGN_EPI = false, bool SP2 = false>
__device__ __forceinline__ void gemm_phase(PG8_LAS unsigned char* lds, const Gemm g, const Sched& S, const Epi& E) {
    const int tid = threadIdx.x, wid = __builtin_amdgcn_readfirstlane(tid >> 6), lane = tid & 63, wr = wid >> 2, wc = wid & 3, fr = lane & 15, fq = lane >> 4;
    const int K = g.K, nt = K / BK;
    unsigned voffA[2], voffB[2];
#pragma unroll
    for (int i = 0; i < 2; ++i) { int R, C; stage_rc(tid * 16 + i * 8192, R, C); const int Rb = Epi::PERM ? ((R & ~31) + perm32(R & 31)) : R;
        voffA[i] = (unsigned)(R * K + C) * 2u; voffB[i] = (unsigned)(Rb * K + C) * 2u; }
    const size_t kstep = (size_t)(BK * 2);
    const size_t hstep = (size_t)HALF * K * 2;
    const size_t tstep = 2 * hstep;
    const unsigned ldsw = (unsigned)wid * 1024u;
    const int aoff = lds_byte(wr * 64 + fr, fq * 8), boff = lds_byte(wc * 32 + fr, fq * 8);
#define PG8_SA(b, h) (((b) * 2 + (h)) * HTB)
#define PG8_SB(b, h) ((4 + (b) * 2 + (h)) * HTB)
#define PG8_STAGE(bufoff, gbase, voff) do { _Pragma("unroll") for (int _i = 0; _i < 2; ++_i) \
        __builtin_amdgcn_global_load_lds((const unsigned*)((const char*)(gbase) + (voff)[_i]), (PG8_LAS unsigned*)(lds + (bufoff) + ldsw + _i * 8192), 16, 0, 0); } while (0)
#define PG8_LDA(dst, b, h) do { _Pragma("unroll") for (int m = 0; m < 4; ++m) _Pragma("unroll") for (int k = 0; k < 2; ++k) dst[m][k] = *(const PG8_LAS bf16x8*)(lds + PG8_SA(b, h) + aoff + m * 2048 + k * 1024); } while (0)
#define PG8_LDB(dst, b, h) do { _Pragma("unroll") for (int n = 0; n < 2; ++n) _Pragma("unroll") for (int k = 0; k < 2; ++k) dst[n][k] = *(const PG8_LAS bf16x8*)(lds + PG8_SB(b, h) + boff + n * 2048 + k * 1024); } while (0)
#define PG8_MMA(ai, bj, At, Bt) do { __builtin_amdgcn_s_setprio(1); _Pragma("unroll") for (int m = 0; m < 4; ++m) _Pragma("unroll") for (int n = 0; n < 2; ++n) _Pragma("unroll") for (int k = 0; k < 2; ++k) \
        acc[ai][bj][m][n] = __builtin_amdgcn_mfma_f32_16x16x32_bf16(Bt[n][k], At[m][k], acc[ai][bj][m][n], 0, 0, 0); __builtin_amdgcn_s_setprio(0); } while (0)
#define PG8_WAIT_V(n) asm volatile("s_waitcnt vmcnt(" #n ")" ::: "memory")
#define PG8_WAIT_L(n) asm volatile("s_waitcnt lgkmcnt(" #n ")" ::: "memory")
#define PG8_BAR __builtin_amdgcn_s_barrier()
#define PG8_SCHED __builtin_amdgcn_sched_barrier(0)
    Unit cur, nxt; int ui = 0;
    if (!S.next(0, cur)) return;
    f32x4 acc[2][2][4][2];
#pragma unroll
    for (int a = 0; a < 2; ++a)
#pragma unroll
        for (int b = 0; b < 2; ++b)
#pragma unroll
            for (int m = 0; m < 4; ++m)
#pragma unroll
                for (int n = 0; n < 2; ++n) acc[a][b][m][n] = (f32x4){0.f, 0.f, 0.f, 0.f};
    bf16x8 At[4][2], B0[2][2], B1[2][2];
    const char* cA = (const char*)g.A + (size_t)cur.pm * tstep; const char* cB = (const char*)g.Bt + (size_t)cur.pn * tstep;
    S.a_ready(cur);
    if constexpr (SP2) {
        PG8_STAGE(PG8_SB(0, 0), cB, voffB); PG8_STAGE(PG8_SB(0, 1), cB + hstep, voffB); PG8_STAGE(PG8_SA(0, 0), cA, voffA); PG8_STAGE(PG8_SA(0, 1), cA + hstep, voffA);
        if (wr == 1) PG8_BAR;
        PG8_WAIT_V(2); PG8_BAR;
        PG8_STAGE(PG8_SB(1, 0), cB + kstep, voffB); PG8_STAGE(PG8_SA(1, 0), cA + kstep, voffA); PG8_STAGE(PG8_SB(1, 1), cB + hstep + kstep, voffB);
        PG8_WAIT_V(6); PG8_BAR;
    } else {
        PG8_STAGE(PG8_SB(0, 0), cB, voffB); PG8_STAGE(PG8_SA(0, 0), cA, voffA); PG8_STAGE(PG8_SB(0, 1), cB + hstep, voffB); PG8_STAGE(PG8_SA(0, 1), cA + hstep, voffA);
        if (wr == 1) PG8_BAR;
        PG8_WAIT_V(4); PG8_BAR;
        PG8_STAGE(PG8_SB(1, 0), cB + kstep, voffB); PG8_STAGE(PG8_SA(1, 0), cA + kstep, voffA); PG8_STAGE(PG8_SB(1, 1), cB + hstep + kstep, voffB);
        PG8_WAIT_V(6); PG8_BAR;
    }
    for (;;) {
        const bool has_next = S.next(ui + 1, nxt);
        const char* nA = has_next ? (const char*)g.A + (size_t)nxt.pm * tstep : cA; const char* nB = has_next ? (const char*)g.Bt + (size_t)nxt.pn * tstep : cB;
        for (int t = 0; t < nt; t += 2) {
            const bool last = (t == nt - 2);
            const char* a1 = cA + (size_t)(t + 1) * kstep;
            const char* a2 = last ? nA : cA + (size_t)(t + 2) * kstep; const char* b2 = last ? nB : cB + (size_t)(t + 2) * kstep;
            const char* a3 = a2 + kstep; const char* b3 = b2 + kstep;
            if (last && has_next) S.a_ready(nxt);
            if constexpr (SP2) {
            PG8_LDB(B0, 0, 0); PG8_LDB(B1, 0, 1); PG8_SCHED; PG8_LDA(At, 0, 0); PG8_STAGE(PG8_SA(1, 1), a1 + hstep, voffA);
            PG8_WAIT_V(8); PG8_WAIT_L(0); PG8_BAR; PG8_MMA(0, 0, At, B0); PG8_MMA(0, 1, At, B1); PG8_BAR; PG8_SCHED;
            PG8_LDA(At, 0, 1); PG8_STAGE(PG8_SB(0, 0), b2, voffB); PG8_STAGE(PG8_SB(0, 1), b2 + hstep, voffB); PG8_STAGE(PG8_SA(0, 0), a2, voffA);
            PG8_WAIT_V(8); PG8_WAIT_L(0); PG8_BAR; PG8_MMA(1, 0, At, B0); PG8_MMA(1, 1, At, B1); PG8_BAR; PG8_SCHED;
            PG8_LDB(B0, 1, 0); PG8_LDB(B1, 1, 1); PG8_SCHED; PG8_LDA(At, 1, 0); PG8_STAGE(PG8_SA(0, 1), a2 + hstep, voffA);
            PG8_WAIT_V(8); PG8_WAIT_L(0); PG8_BAR; PG8_MMA(0, 0, At, B0); PG8_MMA(0, 1, At, B1); PG8_BAR; PG8_SCHED;
            PG8_LDA(At, 1, 1); PG8_STAGE(PG8_SB(1, 0), b3, voffB); PG8_STAGE(PG8_SB(1, 1), b3 + hstep, voffB); PG8_STAGE(PG8_SA(1, 0), a3, voffA);
            PG8_WAIT_V(8); PG8_WAIT_L(0); PG8_BAR; PG8_MMA(1, 0, At, B0); PG8_MMA(1, 1, At, B1); PG8_BAR; PG8_SCHED;
            } else {
            PG8_LDB(B0, 0, 0); PG8_SCHED; PG8_LDA(At, 0, 0); PG8_STAGE(PG8_SA(1, 1), a1 + hstep, voffA);
            PG8_WAIT_L(8); PG8_BAR; PG8_WAIT_L(0); PG8_MMA(0, 0, At, B0); PG8_BAR; PG8_SCHED;
            PG8_LDB(B1, 0, 1); PG8_STAGE(PG8_SB(0, 0), b2, voffB);
            PG8_BAR; PG8_WAIT_L(0); PG8_MMA(0, 1, At, B1); PG8_BAR;
            PG8_LDA(At, 0, 1); PG8_STAGE(PG8_SA(0, 0), a2, voffA);
            PG8_BAR; PG8_WAIT_L(0); PG8_MMA(1, 0, At, B0); PG8_BAR; PG8_SCHED;
            PG8_STAGE(PG8_SB(0, 1), b2 + hstep, voffB);
            PG8_WAIT_V(6); PG8_BAR; PG8_MMA(1, 1, At, B1); PG8_BAR;
            PG8_LDB(B0, 1, 0); PG8_SCHED; PG8_LDA(At, 1, 0); PG8_STAGE(PG8_SA(0, 1), a2 + hstep, voffA);
            PG8_WAIT_L(8); PG8_BAR; PG8_WAIT_L(0); PG8_MMA(0, 0, At, B0); PG8_BAR; PG8_SCHED;
            PG8_LDB(B1, 1, 1); PG8_STAGE(PG8_SB(1, 0), b3, voffB);
            PG8_BAR; PG8_WAIT_L(0); PG8_MMA(0, 1, At, B1); PG8_BAR;
            PG8_LDA(At, 1, 1); PG8_STAGE(PG8_SA(1, 0), a3, voffA);
            PG8_BAR; PG8_WAIT_L(0); PG8_MMA(1, 0, At, B0); PG8_BAR; PG8_SCHED;
            PG8_STAGE(PG8_SB(1, 1), b3 + hstep, voffB);
            PG8_WAIT_V(6); PG8_BAR; PG8_MMA(1, 1, At, B1); PG8_BAR;
            }
        }
        if constexpr (ALIGN_EPI) { if (wr == 0) PG8_BAR; }
        if constexpr (!Epi::AFTER_DRAIN) { E(acc, cur, wr, wc, fr, fq); S.done(cur); }
        if (!has_next) break;
#pragma unroll
        for (int a = 0; a < 2; ++a)
#pragma unroll
            for (int b = 0; b < 2; ++b)
#pragma unroll
                for (int m = 0; m < 4; ++m)
#pragma unroll
                    for (int n = 0; n < 2; ++n) acc[a][b][m][n] = (f32x4){0.f, 0.f, 0.f, 0.f};
        cur = nxt; cA = nA; cB = nB; ++ui;
        if constexpr (ALIGN_EPI) { if (wr == 1) PG8_BAR; }
    }
    PG8_WAIT_V(0);
    if constexpr (!ALIGN_EPI) { if (wr == 0) PG8_BAR; }
    PG8_BAR;
    if constexpr (Epi::AFTER_DRAIN) { E.fused(acc, cur, wr, wc, fr, fq, lds, wid, lane); S.done(cur); }
#undef PG8_SA
#undef PG8_SB
#undef PG8_STAGE
#undef PG8_LDA
#undef PG8_LDB
#undef PG8_MMA
#undef PG8_WAIT_V
#undef PG8_WAIT_L
#undef PG8_BAR
#undef PG8_SCHED
}
}


namespace mk {
using pg8::bf16_t; using pg8::bf16x8; using pg8::f32x4; using pg8::u32x4; using pg8::cvt_pk_bf16; using pg8::Unit;
typedef float f32x16 __attribute__((ext_vector_type(16)));
typedef unsigned u32x2 __attribute__((ext_vector_type(2)));
#define LAS __attribute__((address_space(3)))
#define LDS_WAIT() asm volatile("s_waitcnt lgkmcnt(0)" ::: "memory")

constexpr int S = 8192, D = 4096, NG = 128, DFF = 11008, UPW = 22016, PW = 6144;
constexpr int NC = 16, LC = 512;
constexpr float ALPHA = 1.189207115002721f;
constexpr float LN_EPS = 1e-5f;
constexpr float LAMBDA_INIT = 0.2f;
constexpr float LOG2E = 1.4426950408889634f;
constexpr int LDS_BYTES = 147456, LDS_XB = LDS_BYTES - 16;
constexpr size_t CTL_BAR = 4096;

constexpr size_t MiB = 1ull << 20;
constexpr size_t WS_CTL = 0, WS_XB = 1 * MiB, WS_WIN = 65 * MiB, WS_P = 129 * MiB, WS_VT = 225 * MiB, WS_YG = 257 * MiB, WS_MIXA = 289 * MiB,
                 WS_GH = 1 * MiB, WS_AH = 17 * MiB  , WS_WGLU = 353 * MiB, WS_WOUT = 361 * MiB, WS_WUP = 393 * MiB, WS_WDOWN = 565 * MiB,
                 WS_R1 = 651 * MiB, WS_H1B = 779 * MiB, WS_ACT = 843 * MiB, WS_SSMA = 1015 * MiB, WS_SSMAL = WS_SSMA + 65536, WS_SSMBB = WS_SSMAL + 65536,
                 WS_SSME = 1016 * MiB  , WS_END = 1018 * MiB;

struct Params { const float* in[27]; float* out; unsigned char* ws; int ph_lo, ph_hi; };

__device__ __forceinline__ float wave_sum(float v) {
#pragma unroll
    for (int o = 1; o < 64; o <<= 1) v += __shfl_xor(v, o);
    return v;
}
__device__ __forceinline__ float bf_lo(unsigned w) { return __uint_as_float(w << 16); }
__device__ __forceinline__ float bf_hi(unsigned w) { return __uint_as_float(w & 0xffff0000u); }
__device__ __forceinline__ float gelu_tanh(float y) {
    const float inner = y * (1.0f + 0.044715f * y * y);
    const float e = __builtin_amdgcn_exp2f(inner * (-2.0f * 0.7978845608028654f * LOG2E));
    return y * __builtin_amdgcn_rcpf(1.0f + e);
}
__device__ __forceinline__ float sigmoidf_(float z) { return __builtin_amdgcn_rcpf(1.0f + __builtin_amdgcn_exp2f(-z * LOG2E)); }

template <int MODE> __device__ __forceinline__ int rowmap(int n) {
    if (MODE == 0) return n;
    const int isg = n >= DFF ? 1 : 0; const int c = isg ? n - DFF : n; return 256 * (c >> 7) + 128 * isg + (c & 127);
}
template <int MODE, bool NTST> __device__ __forceinline__ void transpose_tile(const float* __restrict__ W, int K, int N, bf16_t* __restrict__ WT, LAS float* scr, int item, int lane) {
    const int nblk = N / 64;
    const int kb = item / nblk, nb = item % nblk, k0 = kb * 64, n0 = nb * 64;
#pragma unroll 8
    for (int i = 0; i < 64; ++i) scr[i * 65 + lane] = __builtin_nontemporal_load(W + (size_t)(k0 + i) * N + n0 + lane);
    LDS_WAIT();
    const int c = lane & 7;
#pragma unroll
    for (int j = 0; j < 8; ++j) {
        const int n = (lane >> 3) + 8 * j; const LAS float* s = scr + (8 * c) * 65 + n;
        u32x4 o; o.x = cvt_pk_bf16(s[0], s[65]); o.y = cvt_pk_bf16(s[130], s[195]); o.z = cvt_pk_bf16(s[260], s[325]); o.w = cvt_pk_bf16(s[390], s[455]);
        if (NTST) __builtin_nontemporal_store(o, (u32x4*)(WT + (size_t)rowmap<MODE>(n0 + n) * K + k0 + 8 * c));
        else *(u32x4*)(WT + (size_t)rowmap<MODE>(n0 + n) * K + k0 + 8 * c) = o;
    }
    LDS_WAIT();
}

__device__ __forceinline__ void phase0(const Params& p, LAS unsigned char* lds) {
    const int tid = threadIdx.x, lane = tid & 63, wid = tid >> 6;
    const int gw = blockIdx.x * 8 + wid, nw = gridDim.x * 8;
    const int gt = blockIdx.x * 512 + tid, ngt = gridDim.x * 512;
    unsigned char* ws = p.ws;
    {
        const f32x4* x4 = (const f32x4*)p.in[0]; u32x4* xb = (u32x4*)(ws + WS_XB);
        const int n8 = S * D / 8;
        for (int i = gt; i < n8; i += ngt) {
            const f32x4 a = __builtin_nontemporal_load(x4 + 2 * i), b = __builtin_nontemporal_load(x4 + 2 * i + 1);
            u32x4 w; w.x = cvt_pk_bf16(a[0], a[1]); w.y = cvt_pk_bf16(a[2], a[3]); w.z = cvt_pk_bf16(b[0], b[1]); w.w = cvt_pk_bf16(b[2], b[3]);
            xb[i] = w;
        }
    }
    for (int i = gt; i < NG * 64; i += ngt) {
        const int g = i >> 6, n = i & 63;
        const double step = exp((double)p.in[2][g]);
        const double lr = (double)p.in[3][i], li = (double)p.in[4][i];
        const double mag = exp(lr * step); double sn, cs; sincos(li * step, &sn, &cs);
        const double are = mag * cs, aim = mag * sn;
        const double den = lr * lr + li * li, nr = are - 1.0, ni = aim;
        const double zre = (nr * lr + ni * li) / den, zim = (ni * lr - nr * li) / den;
        float* A = (float*)(ws + WS_SSMA); float* AL = (float*)(ws + WS_SSMAL); bf16_t* BB = (bf16_t*)(ws + WS_SSMBB);
        const float are_f = (float)are, aim_f = (float)aim;
        A[2 * i] = are_f; A[2 * i + 1] = aim_f;
        double pr = (double)are_f, pi = (double)aim_f;
#pragma unroll
        for (int s = 0; s < 8; ++s) { const double t = pr * pr - pi * pi; pi = 2.0 * pr * pi; pr = t; }
        AL[2 * i] = (float)pr; AL[2 * i + 1] = (float)pi;
        const float* bre = p.in[5] + (size_t)i * 16; const float* bim = p.in[6] + (size_t)i * 16;
        unsigned wre[8], wim[8];
#pragma unroll
        for (int h = 0; h < 16; h += 2) {
            const double br0 = bre[h], bi0 = bim[h], br1 = bre[h + 1], bi1 = bim[h + 1];
            wre[h >> 1] = cvt_pk_bf16((float)(zre * br0 - zim * bi0), (float)(zre * br1 - zim * bi1));
            wim[h >> 1] = cvt_pk_bf16((float)(zre * bi0 + zim * br0), (float)(zre * bi1 + zim * br1));
        }
        u32x4* dre = (u32x4*)(BB + ((size_t)g * 128 + n) * 16); u32x4* dim = (u32x4*)(BB + ((size_t)g * 128 + 64 + n) * 16);
        dre[0] = (u32x4){wre[0], wre[1], wre[2], wre[3]}; dre[1] = (u32x4){wre[4], wre[5], wre[6], wre[7]};
        dim[0] = (u32x4){wim[0], wim[1], wim[2], wim[3]}; dim[1] = (u32x4){wim[4], wim[5], wim[6], wim[7]};
    }
    if (blockIdx.x == 0) { unsigned* bw = (unsigned*)(ws + WS_CTL + CTL_BAR); for (int i = tid; i < 3456; i += 512) bw[i] = 0u; }
    if (blockIdx.x == 0 && wid == 0) {
        float s1 = p.in[12][lane] * p.in[13][lane] + p.in[12][lane + 64] * p.in[13][lane + 64];
        float s2 = p.in[14][lane] * p.in[15][lane] + p.in[14][lane + 64] * p.in[15][lane + 64];
        s1 = wave_sum(s1); s2 = wave_sum(s2);
        if (lane == 0) ((float*)(ws + WS_CTL))[0] = expf(s1) - expf(s2) + LAMBDA_INIT;
    }
    LAS float* scr = (LAS float*)(lds + wid * (64 * 65 * 4));
    constexpr int T_IN = (D / 64) * (8192 / 64), T_GLU = 32 * 32, T_OUT = 64 * 64, T_UP = (D / 64) * (UPW / 64), T_DN = (DFF / 64) * (D / 64);
    constexpr int E_IN = T_IN, E_GLU = E_IN + T_GLU, E_OUT = E_GLU + T_OUT, E_UP = E_OUT + T_UP, E_DN = E_UP + T_DN;
    for (int it = gw; it < E_DN; it += nw) {
        if (it < E_IN) transpose_tile<0, false>(p.in[1], D, 8192, (bf16_t*)(ws + WS_WIN), scr, it, lane);
        else if (it < E_GLU) transpose_tile<0, true>(p.in[10], 2048, 2048, (bf16_t*)(ws + WS_WGLU), scr, it - E_IN, lane);
        else if (it < E_OUT) transpose_tile<0, true>(p.in[18], D, D, (bf16_t*)(ws + WS_WOUT), scr, it - E_GLU, lane);
        else if (it < E_UP) transpose_tile<1, true>(p.in[21], D, UPW, (bf16_t*)(ws + WS_WUP), scr, it - E_OUT, lane);
        else transpose_tile<0, true>(p.in[24], DFF, D, (bf16_t*)(ws + WS_WDOWN), scr, it - E_UP, lane);
    }
}

template <bool SWAP16> struct EpiBf16PlainT {
    static constexpr bool PERM = true, AFTER_DRAIN = false;
    bf16_t* O; int ldc;
    __device__ __forceinline__ void operator()(const f32x4 (&acc)[2][2][4][2], const Unit& u, int wr, int wc, int fr, int fq) const {
        const int row0 = u.pm * 256 + wr * 64 + fr, col0 = u.pn * 256 + wc * 32 + 8 * fq;
#pragma unroll
        for (int ai = 0; ai < 2; ++ai)
#pragma unroll
            for (int m = 0; m < 4; ++m) { bf16_t* rowp = O + (size_t)(row0 + ai * 128 + m * 16) * ldc + col0;
#pragma unroll
                for (int bj = 0; bj < 2; ++bj) { const f32x4 v0 = acc[ai][bj][m][0], v1 = acc[ai][bj][m][1];
                    u32x4 w; w.x = cvt_pk_bf16(v0[0], v0[1]); w.y = cvt_pk_bf16(v0[2], v0[3]); w.z = cvt_pk_bf16(v1[0], v1[1]); w.w = cvt_pk_bf16(v1[2], v1[3]);
                    if (SWAP16 && (m & 1)) w = (u32x4){w.z, w.w, w.x, w.y};
                    *(u32x4*)(rowp + bj * 128) = w; } }
    }
};
typedef EpiBf16PlainT<false> EpiBf16Plain;
struct EpiGlu {
    static constexpr bool PERM = true, AFTER_DRAIN = false;
    bf16_t* O; int ldo; const bf16_t* YG; const float* bias;
    __device__ __forceinline__ void operator()(const f32x4 (&acc)[2][2][4][2], const Unit& u, int wr, int wc, int fr, int fq) const {
        const int row0 = u.pm * 256 + wr * 64 + fr, col0 = u.pn * 256 + wc * 32 + 8 * fq;
#pragma unroll
        for (int bj = 0; bj < 2; ++bj) {
            const f32x4 b0 = *(const f32x4*)(bias + col0 + bj * 128), b1 = *(const f32x4*)(bias + col0 + bj * 128 + 4);
#pragma unroll
            for (int ai = 0; ai < 2; ++ai)
#pragma unroll
                for (int m = 0; m < 4; ++m) { const size_t row = (size_t)(row0 + ai * 128 + m * 16);
                    const u32x4 y = *(const u32x4*)(YG + row * 2048 + col0 + bj * 128);
                    const f32x4 z0 = acc[ai][bj][m][0] + b0, z1 = acc[ai][bj][m][1] + b1;
                    u32x4 w;
                    w.x = cvt_pk_bf16(bf_lo(y.x) * sigmoidf_(z0[0]), bf_hi(y.x) * sigmoidf_(z0[1]));
                    w.y = cvt_pk_bf16(bf_lo(y.y) * sigmoidf_(z0[2]), bf_hi(y.y) * sigmoidf_(z0[3]));
                    w.z = cvt_pk_bf16(bf_lo(y.z) * sigmoidf_(z1[0]), bf_hi(y.z) * sigmoidf_(z1[1]));
                    w.w = cvt_pk_bf16(bf_lo(y.w) * sigmoidf_(z1[2]), bf_hi(y.w) * sigmoidf_(z1[3]));
                    *(u32x4*)(O + row * ldo + col0 + bj * 128) = w; } }
    }
};
struct EpiResX {
    static constexpr bool PERM = false, AFTER_DRAIN = false;
    bf16_t* CB; const bf16_t* baseB; int ld;
    __device__ __forceinline__ void operator()(const f32x4 (&acc)[2][2][4][2], const Unit& u, int wr, int wc, int fr, int fq) const {
        const int row0 = u.pm * 256 + wr * 64 + fr, col0 = u.pn * 256 + wc * 32 + 4 * fq;
#pragma unroll
        for (int ai = 0; ai < 2; ++ai)
#pragma unroll
            for (int m = 0; m < 4; ++m) { const size_t off = (size_t)(row0 + ai * 128 + m * 16) * ld + col0;
#pragma unroll
                for (int bj = 0; bj < 2; ++bj)
#pragma unroll
                    for (int n = 0; n < 2; ++n) { const u32x2 hb = *(const u32x2*)(baseB + off + bj * 128 + n * 16);
                        const f32x4 b = {bf_lo(hb.x), bf_hi(hb.x), bf_lo(hb.y), bf_hi(hb.y)};
                        const f32x4 r = b * ALPHA + acc[ai][bj][m][n];
                        u32x2 w; w.x = cvt_pk_bf16(r[0], r[1]); w.y = cvt_pk_bf16(r[2], r[3]); *(u32x2*)(CB + off + bj * 128 + n * 16) = w; } }
    }
};
struct EpiResB {
    static constexpr bool PERM = false, AFTER_DRAIN = false;
    bf16_t* CB; const bf16_t* baseB; int ld;
    __device__ __forceinline__ void operator()(const f32x4 (&acc)[2][2][4][2], const Unit& u, int wr, int wc, int fr, int fq) const {
        const int row0 = u.pm * 256 + wr * 64 + fr, col0 = u.pn * 256 + wc * 32 + 4 * fq;
#pragma unroll
        for (int ai = 0; ai < 2; ++ai)
#pragma unroll
            for (int m = 0; m < 4; ++m) { const size_t off = (size_t)(row0 + ai * 128 + m * 16) * ld + col0;
#pragma unroll
                for (int bj = 0; bj < 2; ++bj)
#pragma unroll
                    for (int n = 0; n < 2; ++n) { const u32x2 hb = *(const u32x2*)(baseB + off + bj * 128 + n * 16);
                        const f32x4 b = {bf_lo(hb.x), bf_hi(hb.x), bf_lo(hb.y), bf_hi(hb.y)};
                        const f32x4 r = b * ALPHA + acc[ai][bj][m][n];
                        u32x2 w; w.x = cvt_pk_bf16(r[0], r[1]); w.y = cvt_pk_bf16(r[2], r[3]); *(u32x2*)(CB + off + bj * 128 + n * 16) = w; } }
    }
};
struct EpiConvGate {
    static constexpr bool PERM = true, AFTER_DRAIN = false;
    bf16_t* ACT; bf16_t* GH; bf16_t* AH; const float* cw; const float* cb;
    __device__ __forceinline__ void operator()(f32x4 (&acc)[2][2][4][2], const Unit& u, int wr, int wc, int fr, int fq) const {
        const int ch0 = u.pn * 128 + wc * 32 + 8 * fq;
#pragma unroll
        for (int ai = 0; ai < 2; ++ai) {
            const int strip = 4 * u.pm + 2 * ai + wr;
            if (fr >= 14) { const f32x4 v0 = acc[ai][1][3][0], v1 = acc[ai][1][3][1];
                u32x4 w; w.x = cvt_pk_bf16(v0[0], v0[1]); w.y = cvt_pk_bf16(v0[2], v0[3]); w.z = cvt_pk_bf16(v1[0], v1[1]); w.w = cvt_pk_bf16(v1[2], v1[3]);
                *(u32x4*)(GH + (size_t)(strip * 4 + (fr - 14)) * DFF + ch0) = w; }
            if (fr < 2) { const f32x4 v0 = acc[ai][1][0][0], v1 = acc[ai][1][0][1], a0 = acc[ai][0][0][0], a1 = acc[ai][0][0][1];
                u32x4 w; w.x = cvt_pk_bf16(v0[0], v0[1]); w.y = cvt_pk_bf16(v0[2], v0[3]); w.z = cvt_pk_bf16(v1[0], v1[1]); w.w = cvt_pk_bf16(v1[2], v1[3]);
                *(u32x4*)(GH + (size_t)(strip * 4 + 2 + fr) * DFF + ch0) = w;
                w.x = cvt_pk_bf16(a0[0], a0[1]); w.y = cvt_pk_bf16(a0[2], a0[3]); w.z = cvt_pk_bf16(a1[0], a1[1]); w.w = cvt_pk_bf16(a1[2], a1[3]);
                *(u32x4*)(AH + (size_t)(strip * 2 + fr) * DFF + ch0) = w; }
        }
#define DPPF(x, ctrl) __builtin_bit_cast(float, __builtin_amdgcn_update_dpp(0, __builtin_bit_cast(int, (x)), (ctrl), 0xf, 0xf, true))
#pragma unroll
        for (int n = 0; n < 2; ++n) {
            const f32x4 w0v = *(const f32x4*)(cw + ch0 + 4 * n), w1v = *(const f32x4*)(cw + DFF + ch0 + 4 * n), w2v = *(const f32x4*)(cw + 2 * DFF + ch0 + 4 * n), bv = *(const f32x4*)(cb + ch0 + 4 * n);
#pragma unroll
            for (int e = 0; e < 4; ++e) {
                const float w0 = w0v[e], w1 = w1v[e], w2 = w2v[e], bb = bv[e];
#pragma unroll
                for (int ai = 0; ai < 2; ++ai) {
#pragma unroll
                    for (int m = 0; m < 4; ++m) {
                        const float g = acc[ai][1][m][n][e];
                        float g1 = DPPF(g, 0x111), g2 = DPPF(g, 0x112);
                        if (m > 0) { const float gp = acc[ai][1][m - 1][n][e]; g1 += DPPF(gp, 0x10F); g2 += DPPF(gp, 0x10E); }
                        const float gc = bb + w0 * g2 + w1 * g1 + w2 * g;
                        acc[ai][0][m][n][e] = gc * sigmoidf_(gc) * acc[ai][0][m][n][e];
                    }
                }
            }
        }
#undef DPPF
        const int row0 = u.pm * 256 + wr * 64 + fr;
#pragma unroll
        for (int ai = 0; ai < 2; ++ai)
#pragma unroll
            for (int m = 0; m < 4; ++m) { const f32x4 v0 = acc[ai][0][m][0], v1 = acc[ai][0][m][1];
                u32x4 w; w.x = cvt_pk_bf16(v0[0], v0[1]); w.y = cvt_pk_bf16(v0[2], v0[3]); w.z = cvt_pk_bf16(v1[0], v1[1]); w.w = cvt_pk_bf16(v1[2], v1[3]);
                *(u32x4*)(ACT + (size_t)(row0 + ai * 128 + m * 16) * DFF + ch0) = w; }
    }
};

template <bool OUTF> __device__ __forceinline__ void ln_rows(bf16_t* RB, float* OF, const float* gam, const float* bet) {
    const int lane = threadIdx.x & 63, gw = blockIdx.x * 8 + (threadIdx.x >> 6), nw = gridDim.x * 8;
    for (int row = gw; row < S; row += nw) {
        u32x2* r2 = (u32x2*)(RB + (size_t)row * D) + lane;
        f32x4 v[16]; float s = 0.f;
#pragma unroll
        for (int j = 0; j < 16; ++j) { const u32x2 w = r2[64 * j]; v[j] = (f32x4){bf_lo(w.x), bf_hi(w.x), bf_lo(w.y), bf_hi(w.y)}; s += (v[j][0] + v[j][1]) + (v[j][2] + v[j][3]); }
        const float mean = wave_sum(s) * (1.0f / D); float q = 0.f;
#pragma unroll
        for (int j = 0; j < 16; ++j) { v[j] = v[j] - mean; q += (v[j][0] * v[j][0] + v[j][1] * v[j][1]) + (v[j][2] * v[j][2] + v[j][3] * v[j][3]); }
        const float rstd = 1.0f / sqrtf(wave_sum(q) * (1.0f / D) + LN_EPS);
#pragma unroll
        for (int j = 0; j < 16; ++j) {
            const f32x4 g = ((const f32x4*)gam)[64 * j + lane], b = ((const f32x4*)bet)[64 * j + lane];
            const f32x4 o = v[j] * rstd * g + b;
            if (OUTF) __builtin_nontemporal_store(o, (f32x4*)(OF + (size_t)row * D) + 64 * j + lane);
            else { u32x2 w; w.x = cvt_pk_bf16(o[0], o[1]); w.y = cvt_pk_bf16(o[2], o[3]); r2[64 * j] = w; }
        }
    }
}

template <int PASS> __device__ __forceinline__ void ssm_pass(const Params& p, LAS unsigned char* lds) {
    const int tid = threadIdx.x, lane = tid & 63, wid = tid >> 6, l15 = lane & 15, q4 = lane >> 4;
    const int gw = blockIdx.x * 8 + wid, nw = gridDim.x * 8;
    unsigned char* ws = p.ws;
    const bf16_t* P = (const bf16_t*)(ws + WS_P);
    const float* A = (const float*)(ws + WS_SSMA); const float* AL = (const float*)(ws + WS_SSMAL); const bf16_t* BB = (const bf16_t*)(ws + WS_SSMBB);
    float* E = (float*)(ws + WS_SSME); bf16_t* YG = (bf16_t*)(ws + WS_YG);
    constexpr int NSC = 2 * NC, LSC = LC / 2;
    LAS unsigned char* bu = lds + wid * (2 * 16 * 528);
    for (int item = gw; item < NG * NC; item += nw) {
        const int g = item / NC, c = item % NC;
        const float are = A[2 * (g * 64 + lane)], aim = A[2 * (g * 64 + lane) + 1];
        bf16x8 bbf[8];
#pragma unroll
        for (int blk = 0; blk < 8; ++blk) {
            bbf[blk] = (bf16x8){0, 0, 0, 0, 0, 0, 0, 0};
            if (q4 < 2) bbf[blk] = *(const bf16x8*)(BB + ((size_t)g * 128 + 16 * blk + l15) * 16 + 8 * q4);
        }
        bf16x8 cf[4]; f32x4 dsk = {0.f, 0.f, 0.f, 0.f};
        if (PASS == 2) {
#pragma unroll
            for (int ks = 0; ks < 4; ++ks) {
                const float* src = (ks < 2 ? p.in[7] : p.in[8]) + ((size_t)g * 16 + l15) * 64 + 32 * (ks & 1) + 8 * q4;
                const f32x4 a = *(const f32x4*)src, b = *(const f32x4*)(src + 4); const float sg = ks < 2 ? 1.0f : -1.0f;
                u32x4 w; w.x = cvt_pk_bf16(sg * a[0], sg * a[1]); w.y = cvt_pk_bf16(sg * a[2], sg * a[3]); w.z = cvt_pk_bf16(sg * b[0], sg * b[1]); w.w = cvt_pk_bf16(sg * b[2], sg * b[3]);
                cf[ks] = *(bf16x8*)&w;
            }
            dsk = *(const f32x4*)(p.in[9] + g * 16 + 4 * q4);
        }
        float hre[2] = {0.f, 0.f}, him[2] = {0.f, 0.f};
        if (PASS == 2) {
            const float alr = AL[2 * (g * 64 + lane)], ali = AL[2 * (g * 64 + lane) + 1];
            float cr = 0.f, ci = 0.f;
            for (int cc = 0; cc < 2 * c; ++cc) {
                const float er = E[((size_t)g * NSC + cc) * 128 + lane], ei = E[((size_t)g * NSC + cc) * 128 + 64 + lane];
                const float nr = alr * cr - ali * ci + er, ni = alr * ci + ali * cr + ei; cr = nr; ci = ni;
            }
            hre[0] = cr; him[0] = ci;
            { const float er = E[((size_t)g * NSC + 2 * c) * 128 + lane], ei = E[((size_t)g * NSC + 2 * c) * 128 + 64 + lane];
              hre[1] = alr * cr - ali * ci + er; him[1] = alr * ci + ali * cr + ei; }
        }
        const int t0 = c * LC;
        for (int tile = 0; tile < LSC / 16; ++tile) {
#pragma unroll
            for (int z = 0; z < 2; ++z) {
                const int tb = t0 + LSC * z + 16 * tile;
                bf16x8 uf = (bf16x8){0, 0, 0, 0, 0, 0, 0, 0};
                if (q4 < 2) uf = *(const bf16x8*)(P + (size_t)(tb + l15) * PW + g * 16 + 8 * q4);
#pragma unroll
                for (int blk = 0; blk < 8; ++blk) {
                    f32x4 acc = {0.f, 0.f, 0.f, 0.f};
                    acc = __builtin_amdgcn_mfma_f32_16x16x32_bf16(bbf[blk], uf, acc, 0, 0, 0);
                    *(LAS f32x4*)(bu + z * 8448 + l15 * 528 + (16 * blk + 4 * q4) * 4) = acc;
                }
            }
            LDS_WAIT();
#pragma unroll
            for (int t = 0; t < 16; ++t) {
#pragma unroll
                for (int z = 0; z < 2; ++z) {
                    const float br = *(const LAS float*)(bu + z * 8448 + t * 528 + lane * 4), bi = *(const LAS float*)(bu + z * 8448 + t * 528 + 256 + lane * 4);
                    const float nr = are * hre[z] - aim * him[z] + br, ni = are * him[z] + aim * hre[z] + bi; hre[z] = nr; him[z] = ni;
                    if (PASS == 2) {
                        const unsigned w = cvt_pk_bf16(hre[z], him[z]);
                        *(LAS unsigned short*)(bu + z * 8448 + t * 528 + lane * 2) = (unsigned short)(w & 0xffffu);
                        *(LAS unsigned short*)(bu + z * 8448 + t * 528 + 128 + lane * 2) = (unsigned short)(w >> 16);
                    }
                }
            }
            if (PASS == 2) {
                LDS_WAIT();
#pragma unroll
                for (int z = 0; z < 2; ++z) {
                    const int tb = t0 + LSC * z + 16 * tile;
                    f32x4 y = {0.f, 0.f, 0.f, 0.f};
#pragma unroll
                    for (int ks = 0; ks < 4; ++ks) {
                        const bf16x8 hb = *(const LAS bf16x8*)(bu + z * 8448 + l15 * 528 + ks * 64 + q4 * 16);
                        y = __builtin_amdgcn_mfma_f32_16x16x32_bf16(cf[ks], hb, y, 0, 0, 0);
                    }
                    const u32x2 uu = *(const u32x2*)(P + (size_t)(tb + l15) * PW + g * 16 + 4 * q4);
                    const float y0 = gelu_tanh(y[0] + dsk[0] * bf_lo(uu.x)), y1 = gelu_tanh(y[1] + dsk[1] * bf_hi(uu.x));
                    const float y2 = gelu_tanh(y[2] + dsk[2] * bf_lo(uu.y)), y3 = gelu_tanh(y[3] + dsk[3] * bf_hi(uu.y));
                    u32x2 w; w.x = cvt_pk_bf16(y0, y1); w.y = cvt_pk_bf16(y2, y3);
                    *(u32x2*)(YG + (size_t)(tb + l15) * 2048 + g * 16 + 4 * q4) = w;
                }
                LDS_WAIT();
            }
        }
        if (PASS == 1) {
#pragma unroll
            for (int z = 0; z < 2; ++z) { E[((size_t)g * NSC + 2 * c + z) * 128 + lane] = hre[z]; E[((size_t)g * NSC + 2 * c + z) * 128 + 64 + lane] = him[z]; }
        }
    }
}

constexpr int AT_KB = 64 * 512, AT_VB = 256 * 128, AT_STAGE = AT_KB + AT_VB, AT_TBL = 2 * AT_STAGE, AT_XROW = 1040;
__device__ __forceinline__ int t5_bucket(int rel) {
    const int n = rel < 0 ? -rel : rel; int b;
    if (n < 8) b = n; else if (n < 12) b = 8; else if (n < 16) b = 9; else if (n < 23) b = 10; else if (n < 32) b = 11; else if (n < 46) b = 12; else if (n < 64) b = 13; else if (n < 91) b = 14; else b = 15;
    return b + (rel > 0 ? 16 : 0);
}
__device__ __forceinline__ void attn_item(const Params& p, LAS unsigned char* lds, int head, int j) {
    int tid_ = threadIdx.x; asm volatile("" : "+v"(tid_));
    const int tid = tid_, lane = tid & 63, wid = __builtin_amdgcn_readfirstlane(tid >> 6), l31 = lane & 31, half = lane >> 5;
    const int rg = wid >> 1, c = wid & 1;
    unsigned char* ws = p.ws;
    const bf16_t* P = (const bf16_t*)(ws + WS_P); const bf16_t* VT = (const bf16_t*)(ws + WS_VT); bf16_t* MIXA = (bf16_t*)(ws + WS_MIXA);
    const float lam = ((const float*)(ws + WS_CTL))[0];
    const int q0 = 128 * j, nkt = 2 * j + 2;
    LAS float* tbl = (LAS float*)(lds + AT_TBL);
    if (tid < 320) tbl[tid] = p.in[17][t5_bucket(tid - 256) * 8 + head] * LOG2E;
    const float bfar = p.in[17][15 * 8 + head] * LOG2E;
    const float CS = 0.08838834764831845f * LOG2E;
    const unsigned qoff0 = (unsigned)(((32 * rg + l31) * PW + c * 128 + 8 * half) * 2);
    const char* qbase = (const char*)(P + (size_t)q0 * PW + 2048 + head * 256);
    bf16x8 qf[8];
#pragma unroll
    for (int ks = 0; ks < 8; ++ks) qf[ks] = *(const bf16x8*)(qbase + qoff0 + 32 * ks);
    const char* kgb = (const char*)(P + 4096 + head * 256); const char* vgb = (const char*)(VT + (size_t)head * 256 * S);
#define AT_DMA(kt, buf) do { int ln = lane; asm volatile("" : "+v"(ln)); _Pragma("unroll") for (int i = 0; i < 4; ++i) { \
        const int n_ = 4 * wid + i, kr_ = 2 * n_ + (ln >> 5), kc_ = (ln & 31) ^ (kr_ & 15), vr_ = 8 * n_ + (ln >> 3), vc_ = (ln & 7) ^ ((vr_ >> 1) & 7); \
        const unsigned ko_ = (unsigned)(kr_ * PW + kc_ * 8) * 2u, vo_ = (unsigned)(vr_ * S + vc_ * 8) * 2u; \
        __builtin_amdgcn_global_load_lds((const unsigned*)(kgb + (size_t)(kt) * 64 * PW * 2 + ko_), (LAS unsigned*)(lds + (buf) * AT_STAGE + (4 * wid + i) * 1024), 16, 0, 0); \
        __builtin_amdgcn_global_load_lds((const unsigned*)(vgb + (size_t)(kt) * 128 + vo_), (LAS unsigned*)(lds + (buf) * AT_STAGE + AT_KB + (4 * wid + i) * 1024), 16, 0, 0); } } while (0)
#define AT_VMWAIT() asm volatile("s_waitcnt vmcnt(0)" ::: "memory")
    const int kbase0 = l31 * 512 + c * 256 + (((l31 & 14) | (half ^ (l31 & 1))) << 4);
    const int vbase0 = l31 * 128 + ((half ^ (l31 >> 4)) & 1) * 8 + (((l31 >> 1) & 7) << 4);
    const int xoff0 = (32 * rg + l31) * AT_XROW;
    f32x16 o[8];
#pragma unroll
    for (int db = 0; db < 8; ++db)
#pragma unroll
        for (int r = 0; r < 16; ++r) o[db][r] = 0.f;
    float m_ref = -__builtin_inff(), lsum = 0.f;
#define AT_BAR() do { asm volatile("" ::: "memory"); __builtin_amdgcn_s_barrier(); asm volatile("" ::: "memory"); } while (0)
#define AT_QK(hb) do { bf16x8 kf[8]; \
        _Pragma("unroll") for (int ks = 0; ks < 8; ++ks) kf[ks] = *(const LAS bf16x8*)(Kb + (kbase ^ (ks * 32)) + (hb) * 32 * 512); \
        _Pragma("unroll") for (int r = 0; r < 16; ++r) s[r] = 0.f; \
        _Pragma("unroll") for (int ks = 0; ks < 8; ++ks) s = __builtin_amdgcn_mfma_f32_32x32x16_bf16(kf[ks], qf[ks], s, 0, 0, 0); } while (0)
#define AT_SM(hb) do { \
        const bool near_ = kt >= nkt - 4; float mx; \
        if (near_) { const LAS float* tb = tbl + (kt * 64 + 32 * (hb) + 4 * half - (q0 + 32 * rg + l31) + 256); \
            _Pragma("unroll") for (int r = 0; r < 16; ++r) s[r] = s[r] * CS + tb[(r & 3) + 8 * (r >> 2)]; \
            mx = s[0]; \
            _Pragma("unroll") for (int r = 1; r < 16; ++r) mx = fmaxf(mx, s[r]); \
        } else { mx = s[0]; \
            _Pragma("unroll") for (int r = 1; r < 16; ++r) mx = fmaxf(mx, s[r]); \
            mx = mx * CS + bfar; }                                            \
        mx = fmaxf(mx, __shfl_xor(mx, 32)); \
        if (__any(mx > m_ref + 8.0f)) { \
            const float mn = fmaxf(m_ref, mx); const float al = __builtin_amdgcn_exp2f(m_ref - mn); m_ref = mn; lsum *= al; \
            _Pragma("unroll") for (int db = 0; db < 8; ++db) _Pragma("unroll") for (int r = 0; r < 16; ++r) o[db][r] *= al; } \
        float ps = 0.f; \
        if (near_) { _Pragma("unroll") for (int r = 0; r < 16; ++r) { s[r] = __builtin_amdgcn_exp2f(s[r] - m_ref); ps += s[r]; } } \
        else { const float bm_ = bfar - m_ref; _Pragma("unroll") for (int r = 0; r < 16; ++r) { s[r] = __builtin_amdgcn_exp2f(s[r] * CS + bm_); ps += s[r]; } } \
        lsum += ps; \
        { u32x4 w; \
          w.x = cvt_pk_bf16(s[0], s[1]); w.y = cvt_pk_bf16(s[2], s[3]); w.z = cvt_pk_bf16(s[4], s[5]); w.w = cvt_pk_bf16(s[6], s[7]); pf[0] = *(bf16x8*)&w; \
          w.x = cvt_pk_bf16(s[8], s[9]); w.y = cvt_pk_bf16(s[10], s[11]); w.z = cvt_pk_bf16(s[12], s[13]); w.w = cvt_pk_bf16(s[14], s[15]); pf[1] = *(bf16x8*)&w; } } while (0)
#define AT_VLOAD(hb, db_) do { int vb_ = vbase0 + (db_) * 4096; asm volatile("" : "+v"(vb_)); _Pragma("unroll") for (int s2 = 0; s2 < 2; ++s2) { \
        const u32x2 lo_ = *(const LAS u32x2*)(Vb + (vb_ ^ ((2 * (hb) + s2) * 32))), hi_ = *(const LAS u32x2*)(Vb + (vb_ ^ ((2 * (hb) + s2) * 32 + 16))); \
        vf[(db_) & 1][s2] = (u32x4){lo_.x, lo_.y, hi_.x, hi_.y}; } } while (0)
#define AT_PV(hb) do { u32x4 vf[2][2]; AT_VLOAD(hb, 0); \
        _Pragma("unroll") for (int db = 0; db < 8; ++db) { \
            if (db + 1 < 8) AT_VLOAD(hb, db + 1); \
            o[db] = __builtin_amdgcn_mfma_f32_32x32x16_bf16(*(bf16x8*)&vf[db & 1][0], pf[0], o[db], 0, 0, 0); \
            o[db] = __builtin_amdgcn_mfma_f32_32x32x16_bf16(*(bf16x8*)&vf[db & 1][1], pf[1], o[db], 0, 0, 0); } } while (0)
    AT_DMA(0, 0); AT_VMWAIT();
    __syncthreads();
    if (wid >= 4) AT_BAR();
    f32x16 s; bf16x8 pf[2];
#pragma unroll
    for (int r = 0; r < 16; ++r) s[r] = 0.f;
    pf[0] = (bf16x8){0, 0, 0, 0, 0, 0, 0, 0}; pf[1] = pf[0];
    for (int kt = 0; kt < nkt; ++kt) {
        const int cur = kt & 1;
        const bool more = kt + 1 < nkt;
        const bool active = !(kt == 2 * j + 1 && rg < 2);
        const LAS unsigned char* Kb = lds + cur * AT_STAGE; const LAS unsigned char* Vb = Kb + AT_KB;
        int kbase = kbase0; asm volatile("" : "+v"(kbase));
        if (active) { AT_QK(0); AT_SM(0); }
        AT_BAR();
        if (more) AT_DMA(kt + 1, cur ^ 1);
        if (active) { AT_PV(0); AT_QK(1); }
        AT_BAR();
        if (active) { AT_SM(1); }
        AT_VMWAIT();
        AT_BAR();
        if (active) { AT_PV(1); }
        AT_BAR();
    }
    if (wid < 4) AT_BAR();
#undef AT_BAR
#undef AT_QK
#undef AT_SM
#undef AT_VLOAD
#undef AT_PV
#undef AT_DMA
    const float ltot = lsum + __shfl_xor(lsum, 32);
    const float inv = 1.0f / ltot;
    int xo = xoff0 + 16 * half; asm volatile("" : "+v"(xo));
    if (c == 1) {
        LAS unsigned char* xrow = lds + xo;
        const float f = lam * inv;
#pragma unroll
        for (int db = 0; db < 8; ++db)
#pragma unroll
            for (int r4 = 0; r4 < 4; ++r4) {
                f32x4 v = {o[db][4 * r4] * f, o[db][4 * r4 + 1] * f, o[db][4 * r4 + 2] * f, o[db][4 * r4 + 3] * f};
                *(LAS f32x4*)(xrow + (32 * db + 8 * r4) * 4) = v;
            }
    }
    __syncthreads();
    if (c == 0) {
        asm volatile("" : "+v"(xo));
        LAS unsigned char* xrow = lds + xo;
        float ss = 0.f;
#pragma unroll
        for (int db = 0; db < 8; ++db)
#pragma unroll
            for (int r4 = 0; r4 < 4; ++r4) {
                const f32x4 x1 = *(const LAS f32x4*)(xrow + (32 * db + 8 * r4) * 4);
#pragma unroll
                for (int e = 0; e < 4; ++e) { const float x = o[db][4 * r4 + e] * inv - x1[e]; o[db][4 * r4 + e] = x; ss += x * x; }
                if ((r4 & 1) == 1) __builtin_amdgcn_sched_barrier(0);
            }
        ss += __shfl_xor(ss, 32);
        const float rms = (1.0f - LAMBDA_INIT) / sqrtf(ss * (1.0f / 256.0f) + LN_EPS);
        LDS_WAIT();
        int xb = xoff0 + 8 * half; asm volatile("" : "+v"(xb));
        LAS unsigned char* brow = lds + xb;
        int go = 16 * half; asm volatile("" : "+v"(go));
        const char* gp = (const char*)p.in[16] + go;
#pragma unroll
        for (int db = 0; db < 8; ++db)
#pragma unroll
            for (int r4 = 0; r4 < 4; ++r4) {
                const f32x4 g = *(const f32x4*)(gp + (32 * db + 8 * r4) * 4);
                u32x2 w; w.x = cvt_pk_bf16(o[db][4 * r4] * rms * g[0], o[db][4 * r4 + 1] * rms * g[1]); w.y = cvt_pk_bf16(o[db][4 * r4 + 2] * rms * g[2], o[db][4 * r4 + 3] * rms * g[3]);
                *(LAS u32x2*)(brow + (32 * db + 8 * r4) * 2) = w;
                if ((r4 & 1) == 1) __builtin_amdgcn_sched_barrier(0);
            }
    }
    __syncthreads();
    {
        int co = (tid >> 5) * AT_XROW + (tid & 31) * 16; asm volatile("" : "+v"(co));
        unsigned mo = (unsigned)(((tid >> 5) * D + (tid & 31) * 8) * 2); asm volatile("" : "+v"(mo));
        char* mb = (char*)(MIXA + (size_t)q0 * D + 2048 + head * 256);
#pragma unroll
        for (int i = 0; i < 8; ++i) {
            const u32x4 w = *(const LAS u32x4*)(lds + co + i * 16 * AT_XROW);
            *(u32x4*)(mb + mo + (size_t)i * 16 * D * 2) = w;
        }
    }
    __syncthreads();
}
__device__ __forceinline__ void attn_phase(const Params& p, LAS unsigned char* lds) {
    for (int pr = blockIdx.x; pr < 256; pr += gridDim.x) {
        const int head = pr & 7, i = pr >> 3;
        attn_item(p, lds, head, 63 - i);
        attn_item(p, lds, head, i);
    }
}

__device__ __forceinline__ void unpack8(const u32x4 v, float (&f)[8]) { f[0] = bf_lo(v.x); f[1] = bf_hi(v.x); f[2] = bf_lo(v.y); f[3] = bf_hi(v.y); f[4] = bf_lo(v.z); f[5] = bf_hi(v.z); f[6] = bf_lo(v.w); f[7] = bf_hi(v.w); }
__device__ __forceinline__ void conv_fix(const Params& p) {
    const bf16_t* GH = (const bf16_t*)(p.ws + WS_GH); const bf16_t* AH = (const bf16_t*)(p.ws + WS_AH); bf16_t* ACT = (bf16_t*)(p.ws + WS_ACT);
    const float* cw = p.in[22]; const float* cb = p.in[23];
    const int gt = blockIdx.x * 512 + threadIdx.x, ngt = gridDim.x * 512;
    constexpr int NV = DFF / 8, NSTRIP = S / 64;
    for (int it = gt; it < NV * NSTRIP; it += ngt) {
        const int cv = it % NV, st = it / NV, ch = cv * 8;
        float gm2[8], gm1[8], g0[8], g1[8], a0[8], a1[8];
#pragma unroll
        for (int e = 0; e < 8; ++e) { gm2[e] = 0.f; gm1[e] = 0.f; }
        if (st > 0) { unpack8(*(const u32x4*)(GH + (size_t)((st - 1) * 4 + 0) * DFF + ch), gm2); unpack8(*(const u32x4*)(GH + (size_t)((st - 1) * 4 + 1) * DFF + ch), gm1); }
        unpack8(*(const u32x4*)(GH + (size_t)(st * 4 + 2) * DFF + ch), g0); unpack8(*(const u32x4*)(GH + (size_t)(st * 4 + 3) * DFF + ch), g1);
        unpack8(*(const u32x4*)(AH + (size_t)(st * 2 + 0) * DFF + ch), a0); unpack8(*(const u32x4*)(AH + (size_t)(st * 2 + 1) * DFF + ch), a1);
        float r0[8], r1[8];
#pragma unroll
        for (int e = 0; e < 8; ++e) {
            const float w0 = cw[ch + e], w1 = cw[DFF + ch + e], w2 = cw[2 * DFF + ch + e], bb = cb[ch + e];
            const float c0 = bb + w0 * gm2[e] + w1 * gm1[e] + w2 * g0[e], c1 = bb + w0 * gm1[e] + w1 * g0[e] + w2 * g1[e];
            r0[e] = c0 * sigmoidf_(c0) * a0[e]; r1[e] = c1 * sigmoidf_(c1) * a1[e];
        }
        u32x4 w; w.x = cvt_pk_bf16(r0[0], r0[1]); w.y = cvt_pk_bf16(r0[2], r0[3]); w.z = cvt_pk_bf16(r0[4], r0[5]); w.w = cvt_pk_bf16(r0[6], r0[7]);
        *(u32x4*)(ACT + (size_t)(st * 64) * DFF + ch) = w;
        w.x = cvt_pk_bf16(r1[0], r1[1]); w.y = cvt_pk_bf16(r1[2], r1[3]); w.z = cvt_pk_bf16(r1[4], r1[5]); w.w = cvt_pk_bf16(r1[6], r1[7]);
        *(u32x4*)(ACT + (size_t)(st * 64 + 1) * DFF + ch) = w;
    }
}

#define XB_TMO      128
#define XB_XCNT(j)  (256  + 64 * (j))
#define XB_XSUB(j)  (1280 + 64 * (j))
#define XB_XGEN(j)  (2304 + 64 * (j))
#define XB_TOP      3328
#define XB_TOPGEN   3392
#define XCD_BAR_WORDS 3456
#define XB_SPIN_CAP (1u << 18)

__device__ __forceinline__ unsigned xb_ld(unsigned* p)              { return __hip_atomic_load(p, __ATOMIC_RELAXED, __HIP_MEMORY_SCOPE_AGENT); }
__device__ __forceinline__ unsigned xb_add(unsigned* p, unsigned v) { return __hip_atomic_fetch_add(p, v, __ATOMIC_RELAXED, __HIP_MEMORY_SCOPE_AGENT); }
__device__ __forceinline__ unsigned xb_xcc_id() { return (unsigned)__builtin_amdgcn_s_getreg((3 << 11) | 20) & 0xFu; }
#define XB_SPIN(cond, bar) do { unsigned _sp = 0; while (cond) { __builtin_amdgcn_s_sleep(1); \
    if ((++_sp & 255u) == 0u) { if (xb_ld(&(bar)[XB_TMO])) break; if (_sp > XB_SPIN_CAP) { atomicAdd(&(bar)[XB_TMO], 1u); break; } } } } while (0)

struct XcdBarrier {
    unsigned* bar; unsigned x;
    volatile LAS unsigned* st;
};

__device__ __forceinline__ XcdBarrier xcd_barrier_post(unsigned* bar, volatile LAS unsigned* st) {
    XcdBarrier b; b.bar = bar; b.x = xb_xcc_id(); b.st = st;
    if (threadIdx.x == 0) (void)xb_add(&bar[XB_XCNT(b.x)], 1u);
    return b;
}
__device__ __forceinline__ void xcd_barrier_complete(unsigned* bar, unsigned x, unsigned& nloc, unsigned& nx) {
    const unsigned G = gridDim.x * gridDim.y * gridDim.z;
    unsigned sum, cnt, mine, sp = 0u;
    for (;;) {
        sum = 0u; cnt = 0u; mine = 0u;
#pragma unroll
        for (unsigned j = 0; j < 16; ++j) { const unsigned c = xb_ld(&bar[XB_XCNT(j)]); sum += c; cnt += (c > 0u) ? 1u : 0u; mine = (j == x) ? c : mine; }
        if (sum == G) break;
        __builtin_amdgcn_s_sleep(1);
        if ((++sp & 255u) == 0u) { if (xb_ld(&bar[XB_TMO])) break; if (sp > XB_SPIN_CAP) { atomicAdd(&bar[XB_TMO], 1u); break; } }
    }
    nloc = mine > 0u ? mine : 1u; nx = cnt > 0u ? cnt : 1u;
}

__device__ __forceinline__ void xcd_barrier(const XcdBarrier& b) {
    asm volatile("s_waitcnt vmcnt(0)" ::: "memory");
    __syncthreads();
    if (threadIdx.x == 0) {
        unsigned* bar = b.bar;
        __builtin_amdgcn_s_waitcnt(0);
        unsigned nloc = b.st[0], nx = b.st[1];
        if (nloc == 0u) { xcd_barrier_complete(bar, b.x, nloc, nx); b.st[0] = nloc; b.st[1] = nx; }
        const unsigned old = xb_add(&bar[XB_XSUB(b.x)], 1u);
        const unsigned gen = old / nloc;
        if (old + 1u == (gen + 1u) * nloc) {
            __builtin_amdgcn_fence(__ATOMIC_RELEASE, "agent");
            asm volatile("s_waitcnt vmcnt(0)" ::: "memory");
            const unsigned og = xb_add(&bar[XB_TOP], 1u);
            const unsigned tg = og / nx;
            if (og + 1u == (tg + 1u) * nx) xb_add(&bar[XB_TOPGEN], 1u);
            else XB_SPIN(xb_ld(&bar[XB_TOPGEN]) == tg, bar);
            __builtin_amdgcn_fence(__ATOMIC_ACQUIRE, "agent");
            xb_add(&bar[XB_XGEN(b.x)], 1u);
            asm volatile("s_waitcnt vmcnt(0)" ::: "memory");
        } else {
            XB_SPIN(xb_ld(&bar[XB_XGEN(b.x)]) == gen, bar);
            __builtin_amdgcn_fence(__ATOMIC_ACQUIRE, "agent");
            asm volatile("s_waitcnt vmcnt(0)" ::: "memory");
        }
    }
    __syncthreads();
}

#ifndef GEMM_SP2
#define GEMM_SP2 true
#endif
#ifndef GEMM_ALIGN_EPI
#define GEMM_ALIGN_EPI true
#endif
template <class Epi> __device__ __forceinline__ void run_gemm(LAS unsigned char* lds, const bf16_t* A, const bf16_t* Bt, int M, int N, int K, const Epi& E) {
    pg8::Gemm g{A, Bt, M, N, K}; pg8::StaticOrder So; So.init(M, N, (int)gridDim.x, (int)blockIdx.x);
    pg8::gemm_phase<Epi, pg8::StaticOrder, GEMM_ALIGN_EPI, GEMM_SP2>(lds, g, So, E);
}

__global__ void __launch_bounds__(512, 2) mega(Params p) {
    extern __shared__ __attribute__((aligned(16))) unsigned char shm[];
    LAS unsigned char* lds = (LAS unsigned char*)shm;
    cg::grid_group grid = cg::this_grid();
    unsigned char* ws = p.ws;
#ifndef PHMASK
#define PHMASK 0x7ff
#endif
#define IN(k) ((((PHMASK) >> (k)) & 1) && p.ph_lo <= (k) && (k) < p.ph_hi)
#define SEAM(k) do { if (IN(k) && IN((k) + 1)) xcd_barrier(xbar); } while (0)
    if (threadIdx.x < 4) ((volatile LAS unsigned*)(lds + LDS_XB))[threadIdx.x] = 0u;
    __syncthreads();
    if (IN(0)) phase0(p, lds);
    if (IN(0) && IN(1)) grid.sync();
    XcdBarrier xbar = xcd_barrier_post((unsigned*)(ws + WS_CTL + CTL_BAR), (volatile LAS unsigned*)(lds + LDS_XB));
    if (IN(1)) {
        run_gemm(lds, (const bf16_t*)(ws + WS_XB), (const bf16_t*)(ws + WS_WIN), S, PW, D, EpiBf16Plain{(bf16_t*)(ws + WS_P), PW});
        run_gemm(lds, (const bf16_t*)(ws + WS_WIN) + (size_t)PW * D, (const bf16_t*)(ws + WS_XB), 2048, S, D, EpiBf16PlainT<true>{(bf16_t*)(ws + WS_VT), S});
    }
    SEAM(1);
    if (IN(2)) ssm_pass<1>(p, lds);
    SEAM(2);
    if (IN(3)) {
#ifndef NO_ATT
        attn_phase(p, lds);
#endif
#ifndef NO_SSM2
        ssm_pass<2>(p, lds);
#endif
        __syncthreads(); }
    SEAM(3);
    if (IN(4)) run_gemm(lds, (const bf16_t*)(ws + WS_YG), (const bf16_t*)(ws + WS_WGLU), S, 2048, 2048, EpiGlu{(bf16_t*)(ws + WS_MIXA), D, (const bf16_t*)(ws + WS_YG), p.in[11]});
    SEAM(4);
    if (IN(5)) run_gemm(lds, (const bf16_t*)(ws + WS_MIXA), (const bf16_t*)(ws + WS_WOUT), S, D, D, EpiResX{(bf16_t*)(ws + WS_H1B), (const bf16_t*)(ws + WS_XB), D});
    SEAM(5);
    if (IN(6)) ln_rows<false>((bf16_t*)(ws + WS_H1B), nullptr, p.in[19], p.in[20]);
    SEAM(6);
    if (IN(7)) run_gemm(lds, (const bf16_t*)(ws + WS_H1B), (const bf16_t*)(ws + WS_WUP), S, UPW, D, EpiConvGate{(bf16_t*)(ws + WS_ACT), (bf16_t*)(ws + WS_GH), (bf16_t*)(ws + WS_AH), p.in[22], p.in[23]});
    SEAM(7);
    if (IN(8)) conv_fix(p);
    SEAM(8);
    if (IN(9)) run_gemm(lds, (const bf16_t*)(ws + WS_ACT), (const bf16_t*)(ws + WS_WDOWN), S, D, DFF, EpiResB{(bf16_t*)(ws + WS_R1), (const bf16_t*)(ws + WS_H1B), D});
    SEAM(9);
    if (IN(10)) ln_rows<true>((bf16_t*)(ws + WS_R1), p.out, p.in[25], p.in[26]);
#undef IN
#undef SEAM
}
}

extern "C" void kernel_launch(void* const* d_in, const int* in_sizes, int n_in, void* d_out, int out_size, void* d_ws, size_t ws_size, hipStream_t stream) {
    static int grid = 0;
    if (grid == 0) {
        if (n_in != 27 || ws_size < mk::WS_END) { fprintf(stderr, "kernel_launch: unexpected inputs (n_in %d, ws %zu)\n", n_in, ws_size); grid = -1; return; }
        int dev = 0, cus = 0, per_cu = 0;
        (void)hipGetDevice(&dev); (void)hipDeviceGetAttribute(&cus, hipDeviceAttributeMultiprocessorCount, dev);
        if (hipFuncSetAttribute((const void*)mk::mega, hipFuncAttributeMaxDynamicSharedMemorySize, mk::LDS_BYTES) != hipSuccess) { fprintf(stderr, "kernel_launch: hipFuncSetAttribute failed\n"); grid = -1; return; }
        if (hipOccupancyMaxActiveBlocksPerMultiprocessor(&per_cu, (const void*)mk::mega, 512, mk::LDS_BYTES) != hipSuccess || per_cu < 1) { fprintf(stderr, "kernel_launch: occupancy query says %d\n", per_cu); per_cu = 1; }
        (void)hipGetLastError();
        grid = cus * 1;
        if (grid <= 0) grid = 256;
    }
    if (grid < 0) return;
    mk::Params p{};
    for (int i = 0; i < 27; ++i) p.in[i] = (const float*)d_in[i];
    p.out = (float*)d_out; p.ws = (unsigned char*)d_ws; p.ph_lo = 0; p.ph_hi = 11;
    void* args[] = {&p};
    const hipError_t e = hipLaunchCooperativeKernel((const void*)mk::mega, dim3(grid), dim3(512), args, mk::LDS_BYTES, stream);
    if (e != hipSuccess) fprintf(stderr, "kernel_launch: cooperative launch failed: %s (grid %d)\n", hipGetErrorString(e), grid);
}
```

```cpp
#include <hip/hip_runtime.h>
#include <hip/hip_cooperative_groups.h>
#include <cstdio>
namespace cg = cooperative_groups;
#include <hip/hip_runtime.h>
namespace pg8 {
#define PG8_LAS __attribute__((address_space(3)))
typedef unsigned short bf16_t;
typedef short bf16x8 __attribute__((ext_vector_type(8)));
typedef float f32x4 __attribute__((ext_vector_type(4)));
typedef unsigned u32x4 __attribute__((ext_vector_type(4)));
constexpr int BM = 256, BK = 64, HALF = 128, HTB = HALF * BK * 2  , STAGE_BYTES = 8 * HTB, NXCD = 8, WGM = 4;

__host__ __device__ __forceinline__ int lds_byte(int r, int c) { const int st = (r >> 4) * 2 + (c >> 5), rr = r & 15, cc = c & 31, ob = rr * 64 + cc * 2; return st * 1024 + (ob ^ (((ob >> 9) & 1) << 5)); }
__host__ __device__ __forceinline__ void stage_rc(int b, int& R, int& C) { const int st = b / 1024, sb = b % 1024, swz = sb ^ (((sb >> 9) & 1) << 5); R = (st >> 1) * 16 + swz / 64; C = (st & 1) * 32 + (swz % 64) / 2; }
__host__ __device__ __forceinline__ int perm32(int rho) { const int n = rho >> 4, i = rho & 15; return 8 * (i >> 2) + 4 * n + (i & 3); }

struct Unit { int pm, pn; };
struct Gemm { const bf16_t* A; const bf16_t* Bt; int M, N, K; };

struct StaticOrder {
    int nM, nN, nwg, G, c;
    __host__ __device__ void init(int M, int N, int G_, int c_) { nM = M / BM; nN = N / BM; nwg = nM * nN; G = G_; c = c_; }
    __host__ __device__ bool next(int i, Unit& u) const {
        const long L = (long)i * G + c; if (L >= nwg) return false;
        int wgid = (int)L; { const int q = nwg / NXCD, r = nwg % NXCD, xcd = wgid % NXCD, off = wgid / NXCD; wgid = (xcd < r ? xcd * (q + 1) : r * (q + 1) + (xcd - r) * q) + off; }
        const int nig = WGM * nN, gid = wgid / nig, fm = gid * WGM, gsz = (nM - fm) < WGM ? (nM - fm) : WGM;
        u.pm = fm + ((wgid % nig) % gsz); u.pn = (wgid % nig) / gsz; return true;
    }
    __device__ __forceinline__ void a_ready(const Unit&) const {}
    __device__ __forceinline__ void done(const Unit&) const {}
};
__device__ __forceinline__ unsigned cvt_pk_bf16(float lo, float hi) { unsigned r; asm volatile("v_cvt_pk_bf16_f32 %0, %1, %2" : "=v"(r) : "v"(lo), "v"(hi)); return r; }
template <class Epi, class Sched, bool ALIGN_EPI = false, bool SP2 = false>
__device__ __forceinline__ void gemm_phase(PG8_LAS unsigned char* lds, const Gemm g, const Sched& S, const Epi& E) {
    const int tid = threadIdx.x, wid = __builtin_amdgcn_readfirstlane(tid >> 6), lane = tid & 63, wr = wid >> 2, wc = wid & 3, fr = lane & 15, fq = lane >> 4;
    const int K = g.K, nt = K / BK;
    unsigned voffA[2], voffB[2];
#pragma unroll
    for (int i = 0; i < 2; ++i) { int R, C; stage_rc(tid * 16 + i * 8192, R, C); const int Rb = Epi::PERM ? ((R & ~31) + perm32(R & 31)) : R;
        voffA[i] = (unsigned)(R * K + C) * 2u; voffB[i] = (unsigned)(Rb * K + C) * 2u; }
    const size_t kstep = (size_t)(BK * 2);
    const size_t hstep = (size_t)HALF * K * 2;
    const size_t tstep = 2 * hstep;
    const unsigned ldsw = (unsigned)wid * 1024u;
    const int aoff = lds_byte(wr * 64 + fr, fq * 8), boff = lds_byte(wc * 32 + fr, fq * 8);
#define PG8_SA(b, h) (((b) * 2 + (h)) * HTB)
#define PG8_SB(b, h) ((4 + (b) * 2 + (h)) * HTB)
#define PG8_STAGE(bufoff, gbase, voff) do { _Pragma("unroll") for (int _i = 0; _i < 2; ++_i) \
        __builtin_amdgcn_global_load_lds((const unsigned*)((const char*)(gbase) + (voff)[_i]), (PG8_LAS unsigned*)(lds + (bufoff) + ldsw + _i * 8192), 16, 0, 0); } while (0)
#define PG8_LDA(dst, b, h) do { _Pragma("unroll") for (int m = 0; m < 4; ++m) _Pragma("unroll") for (int k = 0; k < 2; ++k) dst[m][k] = *(const PG8_LAS bf16x8*)(lds + PG8_SA(b, h) + aoff + m * 2048 + k * 1024); } while (0)
#define PG8_LDB(dst, b, h) do { _Pragma("unroll") for (int n = 0; n < 2; ++n) _Pragma("unroll") for (int k = 0; k < 2; ++k) dst[n][k] = *(const PG8_LAS bf16x8*)(lds + PG8_SB(b, h) + boff + n * 2048 + k * 1024); } while (0)
#define PG8_MMA(ai, bj, At, Bt) do { __builtin_amdgcn_s_setprio(1); _Pragma("unroll") for (int m = 0; m < 4; ++m) _Pragma("unroll") for (int n = 0; n < 2; ++n) _Pragma("unroll") for (int k = 0; k < 2; ++k) \
        acc[ai][bj][m][n] = __builtin_amdgcn_mfma_f32_16x16x32_bf16(Bt[n][k], At[m][k], acc[ai][bj][m][n], 0, 0, 0); __builtin_amdgcn_s_setprio(0); } while (0)
#define PG8_WAIT_V(n) asm volatile("s_waitcnt vmcnt(" #n ")" ::: "memory")
#define PG8_WAIT_L(n) asm volatile("s_waitcnt lgkmcnt(" #n ")" ::: "memory")
#define PG8_BAR __builtin_amdgcn_s_barrier()
#define PG8_SCHED __builtin_amdgcn_sched_barrier(0)
    Unit cur, nxt; int ui = 0;
    if (!S.next(0, cur)) return;
    f32x4 acc[2][2][4][2];
#pragma unroll
    for (int a = 0; a < 2; ++a)
#pragma unroll
        for (int b = 0; b < 2; ++b)
#pragma unroll
            for (int m = 0; m < 4; ++m)
#pragma unroll
                for (int n = 0; n < 2; ++n) acc[a][b][m][n] = (f32x4){0.f, 0.f, 0.f, 0.f};
    bf16x8 At[4][2], B0[2][2], B1[2][2];
    const char* cA = (const char*)g.A + (size_t)cur.pm * tstep; const char* cB = (const char*)g.Bt + (size_t)cur.pn * tstep;
    S.a_ready(cur);
    if constexpr (SP2) {
        PG8_STAGE(PG8_SB(0, 0), cB, voffB); PG8_STAGE(PG8_SB(0, 1), cB + hstep, voffB); PG8_STAGE(PG8_SA(0, 0), cA, voffA); PG8_STAGE(PG8_SA(0, 1), cA + hstep, voffA);
        if (wr == 1) PG8_BAR;
        PG8_WAIT_V(2); PG8_BAR;
        PG8_STAGE(PG8_SB(1, 0), cB + kstep, voffB); PG8_STAGE(PG8_SA(1, 0), cA + kstep, voffA); PG8_STAGE(PG8_SB(1, 1), cB + hstep + kstep, voffB);
        PG8_WAIT_V(6); PG8_BAR;
    } else {
        PG8_STAGE(PG8_SB(0, 0), cB, voffB); PG8_STAGE(PG8_SA(0, 0), cA, voffA); PG8_STAGE(PG8_SB(0, 1), cB + hstep, voffB); PG8_STAGE(PG8_SA(0, 1), cA + hstep, voffA);
        if (wr == 1) PG8_BAR;
        PG8_WAIT_V(4); PG8_BAR;
        PG8_STAGE(PG8_SB(1, 0), cB + kstep, voffB); PG8_STAGE(PG8_SA(1, 0), cA + kstep, voffA); PG8_STAGE(PG8_SB(1, 1), cB + hstep + kstep, voffB);
        PG8_WAIT_V(6); PG8_BAR;
    }
    for (;;) {
        const bool has_next = S.next(ui + 1, nxt);
        const char* nA = has_next ? (const char*)g.A + (size_t)nxt.pm * tstep : cA; const char* nB = has_next ? (const char*)g.Bt + (size_t)nxt.pn * tstep : cB;
        for (int t = 0; t < nt; t += 2) {
            const bool last = (t == nt - 2);
            const char* a1 = cA + (size_t)(t + 1) * kstep;
            const char* a2 = last ? nA : cA + (size_t)(t + 2) * kstep; const char* b2 = last ? nB : cB + (size_t)(t + 2) * kstep;
            const char* a3 = a2 + kstep; const char* b3 = b2 + kstep;
            if (last && has_next) S.a_ready(nxt);
            if constexpr (SP2) {
            PG8_LDB(B0, 0, 0); PG8_LDB(B1, 0, 1); PG8_SCHED; PG8_LDA(At, 0, 0); PG8_STAGE(PG8_SA(1, 1), a1 + hstep, voffA);
            PG8_WAIT_V(8); PG8_WAIT_L(0); PG8_BAR; PG8_MMA(0, 0, At, B0); PG8_MMA(0, 1, At, B1); PG8_BAR; PG8_SCHED;
            PG8_LDA(At, 0, 1); PG8_STAGE(PG8_SB(0, 0), b2, voffB); PG8_STAGE(PG8_SB(0, 1), b2 + hstep, voffB); PG8_STAGE(PG8_SA(0, 0), a2, voffA);
            PG8_WAIT_V(8); PG8_WAIT_L(0); PG8_BAR; PG8_MMA(1, 0, At, B0); PG8_MMA(1, 1, At, B1); PG8_BAR; PG8_SCHED;
            PG8_LDB(B0, 1, 0); PG8_LDB(B1, 1, 1); PG8_SCHED; PG8_LDA(At, 1, 0); PG8_STAGE(PG8_SA(0, 1), a2 + hstep, voffA);
            PG8_WAIT_V(8); PG8_WAIT_L(0); PG8_BAR; PG8_MMA(0, 0, At, B0); PG8_MMA(0, 1, At, B1); PG8_BAR; PG8_SCHED;
            PG8_LDA(At, 1, 1); PG8_STAGE(PG8_SB(1, 0), b3, voffB); PG8_STAGE(PG8_SB(1, 1), b3 + hstep, voffB); PG8_STAGE(PG8_SA(1, 0), a3, voffA);
            PG8_WAIT_V(8); PG8_WAIT_L(0); PG8_BAR; PG8_MMA(1, 0, At, B0); PG8_MMA(1, 1, At, B1); PG8_BAR; PG8_SCHED;
            } else {
            PG8_LDB(B0, 0, 0); PG8_SCHED; PG8_LDA(At, 0, 0); PG8_STAGE(PG8_SA(1, 1), a1 + hstep, voffA);
            PG8_WAIT_L(8); PG8_BAR; PG8_WAIT_L(0); PG8_MMA(0, 0, At, B0); PG8_BAR; PG8_SCHED;
            PG8_LDB(B1, 0, 1); PG8_STAGE(PG8_SB(0, 0), b2, voffB);
            PG8_BAR; PG8_WAIT_L(0); PG8_MMA(0, 1, At, B1); PG8_BAR;
            PG8_LDA(At, 0, 1); PG8_STAGE(PG8_SA(0, 0), a2, voffA);
            PG8_BAR; PG8_WAIT_L(0); PG8_MMA(1, 0, At, B0); PG8_BAR; PG8_SCHED;
            PG8_STAGE(PG8_SB(0, 1), b2 + hstep, voffB);
            PG8_WAIT_V(6); PG8_BAR; PG8_MMA(1, 1, At, B1); PG8_BAR;
            PG8_LDB(B0, 1, 0); PG8_SCHED; PG8_LDA(At, 1, 0); PG8_STAGE(PG8_SA(0, 1), a2 + hstep, voffA);
            PG8_WAIT_L(8); PG8_BAR; PG8_WAIT_L(0); PG8_MMA(0, 0, At, B0); PG8_BAR; PG8_SCHED;
            PG8_LDB(B1, 1, 1); PG8_STAGE(PG8_SB(1, 0), b3, voffB);
            PG8_BAR; PG8_WAIT_L(0); PG8_MMA(0, 1, At, B1); PG8_BAR;
            PG8_LDA(At, 1, 1); PG8_STAGE(PG8_SA(1, 0), a3, voffA);
            PG8_BAR; PG8_WAIT_L(0); PG8_MMA(1, 0, At, B0); PG8_BAR; PG8_SCHED;
            PG8_STAGE(PG8_SB(1, 1), b3 + hstep, voffB);
            PG8_WAIT_V(6); PG8_BAR; PG8_MMA(1, 1, At, B1); PG8_BAR;
            }
        }
        if constexpr (ALIGN_EPI) { if (wr == 0) PG8_BAR; }
        if constexpr (!Epi::AFTER_DRAIN) { E(acc, cur, wr, wc, fr, fq); S.done(cur); }
        if (!has_next) break;
#pragma unroll
        for (int a = 0; a < 2; ++a)
#pragma unroll
            for (int b = 0; b < 2; ++b)
#pragma unroll
                for (int m = 0; m < 4; ++m)
#pragma unroll
                    for (int n = 0; n < 2; ++n) acc[a][b][m][n] = (f32x4){0.f, 0.f, 0.f, 0.f};
        cur = nxt; cA = nA; cB = nB; ++ui;
        if constexpr (ALIGN_EPI) { if (wr == 1) PG8_BAR; }
    }
    PG8_WAIT_V(0);
    if constexpr (!ALIGN_EPI) { if (wr == 0) PG8_BAR; }
    PG8_BAR;
    if constexpr (Epi::AFTER_DRAIN) { E.fused(acc, cur, wr, wc, fr, fq, lds, wid, lane); S.done(cur); }
#undef PG8_SA
#undef PG8_SB
#undef PG8_STAGE
#undef PG8_LDA
#undef PG8_LDB
#undef PG8_MMA
#undef PG8_WAIT_V
#undef PG8_WAIT_L
#undef PG8_BAR
#undef PG8_SCHED
}
}


namespace mk {
using pg8::bf16_t; using pg8::bf16x8; using pg8::f32x4; using pg8::u32x4; using pg8::cvt_pk_bf16; using pg8::Unit;
typedef float f32x16 __attribute__((ext_vector_type(16)));
typedef unsigned u32x2 __attribute__((ext_vector_type(2)));
#define LAS __attribute__((address_space(3)))
#define LDS_WAIT() asm volatile("s_waitcnt lgkmcnt(0)" ::: "memory")

constexpr int S = 8192, D = 4096, NG = 128, DFF = 11008, UPW = 22016, PW = 6144;
constexpr int NC = 16, LC = 512;
constexpr float ALPHA = 1.189207115002721f;
constexpr float LN_EPS = 1e-5f;
constexpr float LAMBDA_INIT = 0.2f;
constexpr float LOG2E = 1.4426950408889634f;
constexpr int LDS_BYTES = 147456, LDS_XB = LDS_BYTES - 16;
constexpr size_t CTL_BAR = 4096;

constexpr size_t MiB = 1ull << 20;
constexpr size_t WS_CTL = 0, WS_XB = 1 * MiB, WS_WIN = 65 * MiB, WS_P = 129 * MiB, WS_VT = 225 * MiB, WS_YG = 257 * MiB, WS_MIXA = 289 * MiB,
                 WS_GH = 1 * MiB, WS_AH = 17 * MiB  , WS_WGLU = 353 * MiB, WS_WOUT = 361 * MiB, WS_WUP = 393 * MiB, WS_WDOWN = 565 * MiB,
                 WS_R1 = 651 * MiB, WS_H1B = 779 * MiB, WS_ACT = 843 * MiB, WS_SSMA = 1015 * MiB, WS_SSMAL = WS_SSMA + 65536, WS_SSMBB = WS_SSMAL + 65536,
                 WS_SSME = 1016 * MiB, WS_END = 1017 * MiB;

struct Params { const float* in[27]; float* out; unsigned char* ws; int ph_lo, ph_hi; };

__device__ __forceinline__ float wave_sum(float v) {
#pragma unroll
    for (int o = 1; o < 64; o <<= 1) v += __shfl_xor(v, o);
    return v;
}
__device__ __forceinline__ float bf_lo(unsigned w) { return __uint_as_float(w << 16); }
__device__ __forceinline__ float bf_hi(unsigned w) { return __uint_as_float(w & 0xffff0000u); }
__device__ __forceinline__ float gelu_tanh(float y) {
    const float inner = y * (1.0f + 0.044715f * y * y);
    const float e = __builtin_amdgcn_exp2f(inner * (-2.0f * 0.7978845608028654f * LOG2E));
    return y * __builtin_amdgcn_rcpf(1.0f + e);
}
__device__ __forceinline__ float sigmoidf_(float z) { return __builtin_amdgcn_rcpf(1.0f + __builtin_amdgcn_exp2f(-z * LOG2E)); }

template <int MODE> __device__ __forceinline__ int rowmap(int n) {
    if (MODE == 0) return n;
    const int isg = n >= DFF ? 1 : 0; const int c = isg ? n - DFF : n; return 256 * (c >> 7) + 128 * isg + (c & 127);
}
template <int MODE, bool NTST> __device__ __forceinline__ void transpose_tile(const float* __restrict__ W, int K, int N, bf16_t* __restrict__ WT, LAS float* scr, int item, int lane) {
    const int nblk = N / 64;
    const int kb = item / nblk, nb = item % nblk, k0 = kb * 64, n0 = nb * 64;
#pragma unroll 8
    for (int i = 0; i < 64; ++i) scr[i * 65 + lane] = __builtin_nontemporal_load(W + (size_t)(k0 + i) * N + n0 + lane);
    LDS_WAIT();
    const int c = lane & 7;
#pragma unroll
    for (int j = 0; j < 8; ++j) {
        const int n = (lane >> 3) + 8 * j; const LAS float* s = scr + (8 * c) * 65 + n;
        u32x4 o; o.x = cvt_pk_bf16(s[0], s[65]); o.y = cvt_pk_bf16(s[130], s[195]); o.z = cvt_pk_bf16(s[260], s[325]); o.w = cvt_pk_bf16(s[390], s[455]);
        if (NTST) __builtin_nontemporal_store(o, (u32x4*)(WT + (size_t)rowmap<MODE>(n0 + n) * K + k0 + 8 * c));
        else *(u32x4*)(WT + (size_t)rowmap<MODE>(n0 + n) * K + k0 + 8 * c) = o;
    }
    LDS_WAIT();
}

__device__ __forceinline__ void phase0(const Params& p, LAS unsigned char* lds) {
    const int tid = threadIdx.x, lane = tid & 63, wid = tid >> 6;
    const int gw = blockIdx.x * 8 + wid, nw = gridDim.x * 8;
    const int gt = blockIdx.x * 512 + tid, ngt = gridDim.x * 512;
    unsigned char* ws = p.ws;
    {
        const f32x4* x4 = (const f32x4*)p.in[0]; u32x4* xb = (u32x4*)(ws + WS_XB);
        const int n8 = S * D / 8;
        for (int i = gt; i < n8; i += ngt) {
            const f32x4 a = __builtin_nontemporal_load(x4 + 2 * i), b = __builtin_nontemporal_load(x4 + 2 * i + 1);
            u32x4 w; w.x = cvt_pk_bf16(a[0], a[1]); w.y = cvt_pk_bf16(a[2], a[3]); w.z = cvt_pk_bf16(b[0], b[1]); w.w = cvt_pk_bf16(b[2], b[3]);
            xb[i] = w;
        }
    }
    for (int i = gt; i < NG * 64; i += ngt) {
        const int g = i >> 6, n = i & 63;
        const double step = exp((double)p.in[2][g]);
        const double lr = (double)p.in[3][i], li = (double)p.in[4][i];
        const double mag = exp(lr * step); double sn, cs; sincos(li * step, &sn, &cs);
        const double are = mag * cs, aim = mag * sn;
        const double den = lr * lr + li * li, nr = are - 1.0, ni = aim;
        const double zre = (nr * lr + ni * li) / den, zim = (ni * lr - nr * li) / den;
        float* A = (float*)(ws + WS_SSMA); float* AL = (float*)(ws + WS_SSMAL); bf16_t* BB = (bf16_t*)(ws + WS_SSMBB);
        const float are_f = (float)are, aim_f = (float)aim;
        A[2 * i] = are_f; A[2 * i + 1] = aim_f;
        double pr = (double)are_f, pi = (double)aim_f;
#pragma unroll
        for (int s = 0; s < 9; ++s) { const double t = pr * pr - pi * pi; pi = 2.0 * pr * pi; pr = t; }
        AL[2 * i] = (float)pr; AL[2 * i + 1] = (float)pi;
        const float* bre = p.in[5] + (size_t)i * 16; const float* bim = p.in[6] + (size_t)i * 16;
        unsigned wre[8], wim[8];
#pragma unroll
        for (int h = 0; h < 16; h += 2) {
            const double br0 = bre[h], bi0 = bim[h], br1 = bre[h + 1], bi1 = bim[h + 1];
            wre[h >> 1] = cvt_pk_bf16((float)(zre * br0 - zim * bi0), (float)(zre * br1 - zim * bi1));
            wim[h >> 1] = cvt_pk_bf16((float)(zre * bi0 + zim * br0), (float)(zre * bi1 + zim * br1));
        }
        u32x4* dre = (u32x4*)(BB + ((size_t)g * 128 + n) * 16); u32x4* dim = (u32x4*)(BB + ((size_t)g * 128 + 64 + n) * 16);
        dre[0] = (u32x4){wre[0], wre[1], wre[2], wre[3]}; dre[1] = (u32x4){wre[4], wre[5], wre[6], wre[7]};
        dim[0] = (u32x4){wim[0], wim[1], wim[2], wim[3]}; dim[1] = (u32x4){wim[4], wim[5], wim[6], wim[7]};
    }
    if (blockIdx.x == 0) { unsigned* bw = (unsigned*)(ws + WS_CTL + CTL_BAR); for (int i = tid; i < 3456; i += 512) bw[i] = 0u; }
    if (blockIdx.x == 0 && wid == 0) {
        float s1 = p.in[12][lane] * p.in[13][lane] + p.in[12][lane + 64] * p.in[13][lane + 64];
        float s2 = p.in[14][lane] * p.in[15][lane] + p.in[14][lane + 64] * p.in[15][lane + 64];
        s1 = wave_sum(s1); s2 = wave_sum(s2);
        if (lane == 0) ((float*)(ws + WS_CTL))[0] = expf(s1) - expf(s2) + LAMBDA_INIT;
    }
    LAS float* scr = (LAS float*)(lds + wid * (64 * 65 * 4));
    constexpr int T_IN = (D / 64) * (8192 / 64), T_GLU = 32 * 32, T_OUT = 64 * 64, T_UP = (D / 64) * (UPW / 64), T_DN = (DFF / 64) * (D / 64);
    constexpr int E_IN = T_IN, E_GLU = E_IN + T_GLU, E_OUT = E_GLU + T_OUT, E_UP = E_OUT + T_UP, E_DN = E_UP + T_DN;
    for (int it = gw; it < E_DN; it += nw) {
        if (it < E_IN) transpose_tile<0, false>(p.in[1], D, 8192, (bf16_t*)(ws + WS_WIN), scr, it, lane);
        else if (it < E_GLU) transpose_tile<0, true>(p.in[10], 2048, 2048, (bf16_t*)(ws + WS_WGLU), scr, it - E_IN, lane);
        else if (it < E_OUT) transpose_tile<0, true>(p.in[18], D, D, (bf16_t*)(ws + WS_WOUT), scr, it - E_GLU, lane);
        else if (it < E_UP) transpose_tile<1, true>(p.in[21], D, UPW, (bf16_t*)(ws + WS_WUP), scr, it - E_OUT, lane);
        else transpose_tile<0, true>(p.in[24], DFF, D, (bf16_t*)(ws + WS_WDOWN), scr, it - E_UP, lane);
    }
}

template <bool SWAP16> struct EpiBf16PlainT {
    static constexpr bool PERM = true, AFTER_DRAIN = false;
    bf16_t* O; int ldc;
    __device__ __forceinline__ void operator()(const f32x4 (&acc)[2][2][4][2], const Unit& u, int wr, int wc, int fr, int fq) const {
        const int row0 = u.pm * 256 + wr * 64 + fr, col0 = u.pn * 256 + wc * 32 + 8 * fq;
#pragma unroll
        for (int ai = 0; ai < 2; ++ai)
#pragma unroll
            for (int m = 0; m < 4; ++m) { bf16_t* rowp = O + (size_t)(row0 + ai * 128 + m * 16) * ldc + col0;
#pragma unroll
                for (int bj = 0; bj < 2; ++bj) { const f32x4 v0 = acc[ai][bj][m][0], v1 = acc[ai][bj][m][1];
                    u32x4 w; w.x = cvt_pk_bf16(v0[0], v0[1]); w.y = cvt_pk_bf16(v0[2], v0[3]); w.z = cvt_pk_bf16(v1[0], v1[1]); w.w = cvt_pk_bf16(v1[2], v1[3]);
                    if (SWAP16 && (m & 1)) w = (u32x4){w.z, w.w, w.x, w.y};
                    *(u32x4*)(rowp + bj * 128) = w; } }
    }
};
typedef EpiBf16PlainT<false> EpiBf16Plain;
struct EpiGlu {
    static constexpr bool PERM = true, AFTER_DRAIN = false;
    bf16_t* O; int ldo; const bf16_t* YG; const float* bias;
    __device__ __forceinline__ void operator()(const f32x4 (&acc)[2][2][4][2], const Unit& u, int wr, int wc, int fr, int fq) const {
        const int row0 = u.pm * 256 + wr * 64 + fr, col0 = u.pn * 256 + wc * 32 + 8 * fq;
#pragma unroll
        for (int bj = 0; bj < 2; ++bj) {
            const f32x4 b0 = *(const f32x4*)(bias + col0 + bj * 128), b1 = *(const f32x4*)(bias + col0 + bj * 128 + 4);
#pragma unroll
            for (int ai = 0; ai < 2; ++ai)
#pragma unroll
                for (int m = 0; m < 4; ++m) { const size_t row = (size_t)(row0 + ai * 128 + m * 16);
                    const u32x4 y = *(const u32x4*)(YG + row * 2048 + col0 + bj * 128);
                    const f32x4 z0 = acc[ai][bj][m][0] + b0, z1 = acc[ai][bj][m][1] + b1;
                    u32x4 w;
                    w.x = cvt_pk_bf16(bf_lo(y.x) * sigmoidf_(z0[0]), bf_hi(y.x) * sigmoidf_(z0[1]));
                    w.y = cvt_pk_bf16(bf_lo(y.y) * sigmoidf_(z0[2]), bf_hi(y.y) * sigmoidf_(z0[3]));
                    w.z = cvt_pk_bf16(bf_lo(y.z) * sigmoidf_(z1[0]), bf_hi(y.z) * sigmoidf_(z1[1]));
                    w.w = cvt_pk_bf16(bf_lo(y.w) * sigmoidf_(z1[2]), bf_hi(y.w) * sigmoidf_(z1[3]));
                    *(u32x4*)(O + row * ldo + col0 + bj * 128) = w; } }
    }
};
struct EpiResX {
    static constexpr bool PERM = false, AFTER_DRAIN = false;
    bf16_t* CB; const bf16_t* baseB; int ld;
    __device__ __forceinline__ void operator()(const f32x4 (&acc)[2][2][4][2], const Unit& u, int wr, int wc, int fr, int fq) const {
        const int row0 = u.pm * 256 + wr * 64 + fr, col0 = u.pn * 256 + wc * 32 + 4 * fq;
#pragma unroll
        for (int ai = 0; ai < 2; ++ai)
#pragma unroll
            for (int m = 0; m < 4; ++m) { const size_t off = (size_t)(row0 + ai * 128 + m * 16) * ld + col0;
#pragma unroll
                for (int bj = 0; bj < 2; ++bj)
#pragma unroll
                    for (int n = 0; n < 2; ++n) { const u32x2 hb = *(const u32x2*)(baseB + off + bj * 128 + n * 16);
                        const f32x4 b = {bf_lo(hb.x), bf_hi(hb.x), bf_lo(hb.y), bf_hi(hb.y)};
                        const f32x4 r = b * ALPHA + acc[ai][bj][m][n];
                        u32x2 w; w.x = cvt_pk_bf16(r[0], r[1]); w.y = cvt_pk_bf16(r[2], r[3]); *(u32x2*)(CB + off + bj * 128 + n * 16) = w; } }
    }
};
struct EpiResB {
    static constexpr bool PERM = false, AFTER_DRAIN = false;
    bf16_t* CB; const bf16_t* baseB; int ld;
    __device__ __forceinline__ void operator()(const f32x4 (&acc)[2][2][4][2], const Unit& u, int wr, int wc, int fr, int fq) const {
        const int row0 = u.pm * 256 + wr * 64 + fr, col0 = u.pn * 256 + wc * 32 + 4 * fq;
#pragma unroll
        for (int ai = 0; ai < 2; ++ai)
#pragma unroll
            for (int m = 0; m < 4; ++m) { const size_t off = (size_t)(row0 + ai * 128 + m * 16) * ld + col0;
#pragma unroll
                for (int bj = 0; bj < 2; ++bj)
#pragma unroll
                    for (int n = 0; n < 2; ++n) { const u32x2 hb = *(const u32x2*)(baseB + off + bj * 128 + n * 16);
                        const f32x4 b = {bf_lo(hb.x), bf_hi(hb.x), bf_lo(hb.y), bf_hi(hb.y)};
                        const f32x4 r = b * ALPHA + acc[ai][bj][m][n];
                        u32x2 w; w.x = cvt_pk_bf16(r[0], r[1]); w.y = cvt_pk_bf16(r[2], r[3]); *(u32x2*)(CB + off + bj * 128 + n * 16) = w; } }
    }
};
struct EpiConvGate {
    static constexpr bool PERM = true, AFTER_DRAIN = false;
    bf16_t* ACT; bf16_t* GH; bf16_t* AH; const float* cw; const float* cb;
    __device__ __forceinline__ void operator()(f32x4 (&acc)[2][2][4][2], const Unit& u, int wr, int wc, int fr, int fq) const {
        const int ch0 = u.pn * 128 + wc * 32 + 8 * fq;
#pragma unroll
        for (int ai = 0; ai < 2; ++ai) {
            const int strip = 4 * u.pm + 2 * ai + wr;
            if (fr >= 14) { const f32x4 v0 = acc[ai][1][3][0], v1 = acc[ai][1][3][1];
                u32x4 w; w.x = cvt_pk_bf16(v0[0], v0[1]); w.y = cvt_pk_bf16(v0[2], v0[3]); w.z = cvt_pk_bf16(v1[0], v1[1]); w.w = cvt_pk_bf16(v1[2], v1[3]);
                *(u32x4*)(GH + (size_t)(strip * 4 + (fr - 14)) * DFF + ch0) = w; }
            if (fr < 2) { const f32x4 v0 = acc[ai][1][0][0], v1 = acc[ai][1][0][1], a0 = acc[ai][0][0][0], a1 = acc[ai][0][0][1];
                u32x4 w; w.x = cvt_pk_bf16(v0[0], v0[1]); w.y = cvt_pk_bf16(v0[2], v0[3]); w.z = cvt_pk_bf16(v1[0], v1[1]); w.w = cvt_pk_bf16(v1[2], v1[3]);
                *(u32x4*)(GH + (size_t)(strip * 4 + 2 + fr) * DFF + ch0) = w;
                w.x = cvt_pk_bf16(a0[0], a0[1]); w.y = cvt_pk_bf16(a0[2], a0[3]); w.z = cvt_pk_bf16(a1[0], a1[1]); w.w = cvt_pk_bf16(a1[2], a1[3]);
                *(u32x4*)(AH + (size_t)(strip * 2 + fr) * DFF + ch0) = w; }
        }
#define DPPF(x, ctrl) __builtin_bit_cast(float, __builtin_amdgcn_update_dpp(0, __builtin_bit_cast(int, (x)), (ctrl), 0xf, 0xf, true))
#pragma unroll
        for (int n = 0; n < 2; ++n) {
            const f32x4 w0v = *(const f32x4*)(cw + ch0 + 4 * n), w1v = *(const f32x4*)(cw + DFF + ch0 + 4 * n), w2v = *(const f32x4*)(cw + 2 * DFF + ch0 + 4 * n), bv = *(const f32x4*)(cb + ch0 + 4 * n);
#pragma unroll
            for (int e = 0; e < 4; ++e) {
                const float w0 = w0v[e], w1 = w1v[e], w2 = w2v[e], bb = bv[e];
#pragma unroll
                for (int ai = 0; ai < 2; ++ai) {
#pragma unroll
                    for (int m = 0; m < 4; ++m) {
                        const float g = acc[ai][1][m][n][e];
                        float g1 = DPPF(g, 0x111), g2 = DPPF(g, 0x112);
                        if (m > 0) { const float gp = acc[ai][1][m - 1][n][e]; g1 += DPPF(gp, 0x10F); g2 += DPPF(gp, 0x10E); }
                        const float gc = bb + w0 * g2 + w1 * g1 + w2 * g;
                        acc[ai][0][m][n][e] = gc * sigmoidf_(gc) * acc[ai][0][m][n][e];
                    }
                }
            }
        }
#undef DPPF
        const int row0 = u.pm * 256 + wr * 64 + fr;
#pragma unroll
        for (int ai = 0; ai < 2; ++ai)
#pragma unroll
            for (int m = 0; m < 4; ++m) { const f32x4 v0 = acc[ai][0][m][0], v1 = acc[ai][0][m][1];
                u32x4 w; w.x = cvt_pk_bf16(v0[0], v0[1]); w.y = cvt_pk_bf16(v0[2], v0[3]); w.z = cvt_pk_bf16(v1[0], v1[1]); w.w = cvt_pk_bf16(v1[2], v1[3]);
                *(u32x4*)(ACT + (size_t)(row0 + ai * 128 + m * 16) * DFF + ch0) = w; }
    }
};

template <bool OUTF> __device__ __forceinline__ void ln_rows(bf16_t* RB, float* OF, const float* gam, const float* bet) {
    const int lane = threadIdx.x & 63, gw = blockIdx.x * 8 + (threadIdx.x >> 6), nw = gridDim.x * 8;
    for (int row = gw; row < S; row += nw) {
        u32x2* r2 = (u32x2*)(RB + (size_t)row * D) + lane;
        f32x4 v[16]; float s = 0.f;
#pragma unroll
        for (int j = 0; j < 16; ++j) { const u32x2 w = r2[64 * j]; v[j] = (f32x4){bf_lo(w.x), bf_hi(w.x), bf_lo(w.y), bf_hi(w.y)}; s += (v[j][0] + v[j][1]) + (v[j][2] + v[j][3]); }
        const float mean = wave_sum(s) * (1.0f / D); float q = 0.f;
#pragma unroll
        for (int j = 0; j < 16; ++j) { v[j] = v[j] - mean; q += (v[j][0] * v[j][0] + v[j][1] * v[j][1]) + (v[j][2] * v[j][2] + v[j][3] * v[j][3]); }
        const float rstd = 1.0f / sqrtf(wave_sum(q) * (1.0f / D) + LN_EPS);
#pragma unroll
        for (int j = 0; j < 16; ++j) {
            const f32x4 g = ((const f32x4*)gam)[64 * j + lane], b = ((const f32x4*)bet)[64 * j + lane];
            const f32x4 o = v[j] * rstd * g + b;
            if (OUTF) __builtin_nontemporal_store(o, (f32x4*)(OF + (size_t)row * D) + 64 * j + lane);
            else { u32x2 w; w.x = cvt_pk_bf16(o[0], o[1]); w.y = cvt_pk_bf16(o[2], o[3]); r2[64 * j] = w; }
        }
    }
}

template <int PASS> __device__ __forceinline__ void ssm_pass(const Params& p, LAS unsigned char* lds) {
    const int tid = threadIdx.x, lane = tid & 63, wid = tid >> 6, l15 = lane & 15, q4 = lane >> 4;
    const int gw = blockIdx.x * 8 + wid, nw = gridDim.x * 8;
    unsigned char* ws = p.ws;
    const bf16_t* P = (const bf16_t*)(ws + WS_P);
    const float* A = (const float*)(ws + WS_SSMA); const float* AL = (const float*)(ws + WS_SSMAL); const bf16_t* BB = (const bf16_t*)(ws + WS_SSMBB);
    float* E = (float*)(ws + WS_SSME); bf16_t* YG = (bf16_t*)(ws + WS_YG);
    LAS unsigned char* bu = lds + wid * (16 * 528);
    for (int item = gw; item < NG * NC; item += nw) {
        const int g = item / NC, c = item % NC;
        const float are = A[2 * (g * 64 + lane)], aim = A[2 * (g * 64 + lane) + 1];
        bf16x8 bbf[8];
#pragma unroll
        for (int blk = 0; blk < 8; ++blk) {
            bbf[blk] = (bf16x8){0, 0, 0, 0, 0, 0, 0, 0};
            if (q4 < 2) bbf[blk] = *(const bf16x8*)(BB + ((size_t)g * 128 + 16 * blk + l15) * 16 + 8 * q4);
        }
        bf16x8 cf[4]; f32x4 dsk = {0.f, 0.f, 0.f, 0.f};
        if (PASS == 2) {
#pragma unroll
            for (int ks = 0; ks < 4; ++ks) {
                const float* src = (ks < 2 ? p.in[7] : p.in[8]) + ((size_t)g * 16 + l15) * 64 + 32 * (ks & 1) + 8 * q4;
                const f32x4 a = *(const f32x4*)src, b = *(const f32x4*)(src + 4); const float sg = ks < 2 ? 1.0f : -1.0f;
                u32x4 w; w.x = cvt_pk_bf16(sg * a[0], sg * a[1]); w.y = cvt_pk_bf16(sg * a[2], sg * a[3]); w.z = cvt_pk_bf16(sg * b[0], sg * b[1]); w.w = cvt_pk_bf16(sg * b[2], sg * b[3]);
                cf[ks] = *(bf16x8*)&w;
            }
            dsk = *(const f32x4*)(p.in[9] + g * 16 + 4 * q4);
        }
        float hre = 0.f, him = 0.f;
        if (PASS == 2) {
            const float alr = AL[2 * (g * 64 + lane)], ali = AL[2 * (g * 64 + lane) + 1];
            for (int cc = 0; cc < c; ++cc) {
                const float er = E[((size_t)g * NC + cc) * 128 + lane], ei = E[((size_t)g * NC + cc) * 128 + 64 + lane];
                const float nr = alr * hre - ali * him + er, ni = alr * him + ali * hre + ei; hre = nr; him = ni;
            }
        }
        const int t0 = c * LC;
        for (int tile = 0; tile < LC / 16; ++tile) {
            const int tb = t0 + 16 * tile;
            bf16x8 uf = (bf16x8){0, 0, 0, 0, 0, 0, 0, 0};
            if (q4 < 2) uf = *(const bf16x8*)(P + (size_t)(tb + l15) * PW + g * 16 + 8 * q4);
#pragma unroll
            for (int blk = 0; blk < 8; ++blk) {
                f32x4 acc = {0.f, 0.f, 0.f, 0.f};
                acc = __builtin_amdgcn_mfma_f32_16x16x32_bf16(bbf[blk], uf, acc, 0, 0, 0);
                *(LAS f32x4*)(bu + l15 * 528 + (16 * blk + 4 * q4) * 4) = acc;
            }
            LDS_WAIT();
#pragma unroll
            for (int t = 0; t < 16; ++t) {
                const float br = *(const LAS float*)(bu + t * 528 + lane * 4), bi = *(const LAS float*)(bu + t * 528 + 256 + lane * 4);
                const float nr = are * hre - aim * him + br, ni = are * him + aim * hre + bi; hre = nr; him = ni;
                if (PASS == 2) {
                    const unsigned w = cvt_pk_bf16(hre, him);
                    *(LAS unsigned short*)(bu + t * 528 + lane * 2) = (unsigned short)(w & 0xffffu);
                    *(LAS unsigned short*)(bu + t * 528 + 128 + lane * 2) = (unsigned short)(w >> 16);
                }
            }
            if (PASS == 2) {
                LDS_WAIT();
                f32x4 y = {0.f, 0.f, 0.f, 0.f};
#pragma unroll
                for (int ks = 0; ks < 4; ++ks) {
                    const bf16x8 hb = *(const LAS bf16x8*)(bu + l15 * 528 + ks * 64 + q4 * 16);
                    y = __builtin_amdgcn_mfma_f32_16x16x32_bf16(cf[ks], hb, y, 0, 0, 0);
                }
                const u32x2 uu = *(const u32x2*)(P + (size_t)(tb + l15) * PW + g * 16 + 4 * q4);
                const float y0 = gelu_tanh(y[0] + dsk[0] * bf_lo(uu.x)), y1 = gelu_tanh(y[1] + dsk[1] * bf_hi(uu.x));
                const float y2 = gelu_tanh(y[2] + dsk[2] * bf_lo(uu.y)), y3 = gelu_tanh(y[3] + dsk[3] * bf_hi(uu.y));
                u32x2 w; w.x = cvt_pk_bf16(y0, y1); w.y = cvt_pk_bf16(y2, y3);
                *(u32x2*)(YG + (size_t)(tb + l15) * 2048 + g * 16 + 4 * q4) = w;
                LDS_WAIT();
            }
        }
        if (PASS == 1) { E[((size_t)g * NC + c) * 128 + lane] = hre; E[((size_t)g * NC + c) * 128 + 64 + lane] = him; }
    }
}

constexpr int AT_KB = 64 * 512, AT_VB = 256 * 128, AT_STAGE = AT_KB + AT_VB, AT_TBL = 2 * AT_STAGE, AT_XROW = 1040;
__device__ __forceinline__ int t5_bucket(int rel) {
    const int n = rel < 0 ? -rel : rel; int b;
    if (n < 8) b = n; else if (n < 12) b = 8; else if (n < 16) b = 9; else if (n < 23) b = 10; else if (n < 32) b = 11; else if (n < 46) b = 12; else if (n < 64) b = 13; else if (n < 91) b = 14; else b = 15;
    return b + (rel > 0 ? 16 : 0);
}
__device__ __forceinline__ void attn_item(const Params& p, LAS unsigned char* lds, int head, int j) {
    int tid_ = threadIdx.x; asm volatile("" : "+v"(tid_));
    const int tid = tid_, lane = tid & 63, wid = __builtin_amdgcn_readfirstlane(tid >> 6), l31 = lane & 31, half = lane >> 5;
    const int rg = wid >> 1, c = wid & 1;
    unsigned char* ws = p.ws;
    const bf16_t* P = (const bf16_t*)(ws + WS_P); const bf16_t* VT = (const bf16_t*)(ws + WS_VT); bf16_t* MIXA = (bf16_t*)(ws + WS_MIXA);
    const float lam = ((const float*)(ws + WS_CTL))[0];
    const int q0 = 128 * j, nkt = 2 * j + 2;
    LAS float* tbl = (LAS float*)(lds + AT_TBL);
    if (tid < 320) tbl[tid] = p.in[17][t5_bucket(tid - 256) * 8 + head] * LOG2E;
    const float bfar = p.in[17][15 * 8 + head] * LOG2E;
    const float CS = 0.08838834764831845f * LOG2E;
    const unsigned qoff0 = (unsigned)(((32 * rg + l31) * PW + c * 128 + 8 * half) * 2);
    const char* qbase = (const char*)(P + (size_t)q0 * PW + 2048 + head * 256);
    bf16x8 qf[8];
#pragma unroll
    for (int ks = 0; ks < 8; ++ks) qf[ks] = *(const bf16x8*)(qbase + qoff0 + 32 * ks);
    const char* kgb = (const char*)(P + 4096 + head * 256); const char* vgb = (const char*)(VT + (size_t)head * 256 * S);
#define AT_DMA(kt, buf) do { int ln = lane; asm volatile("" : "+v"(ln)); _Pragma("unroll") for (int i = 0; i < 4; ++i) { \
        const int n_ = 4 * wid + i, kr_ = 2 * n_ + (ln >> 5), kc_ = (ln & 31) ^ (kr_ & 15), vr_ = 8 * n_ + (ln >> 3), vc_ = (ln & 7) ^ ((vr_ >> 1) & 7); \
        const unsigned ko_ = (unsigned)(kr_ * PW + kc_ * 8) * 2u, vo_ = (unsigned)(vr_ * S + vc_ * 8) * 2u; \
        __builtin_amdgcn_global_load_lds((const unsigned*)(kgb + (size_t)(kt) * 64 * PW * 2 + ko_), (LAS unsigned*)(lds + (buf) * AT_STAGE + (4 * wid + i) * 1024), 16, 0, 0); \
        __builtin_amdgcn_global_load_lds((const unsigned*)(vgb + (size_t)(kt) * 128 + vo_), (LAS unsigned*)(lds + (buf) * AT_STAGE + AT_KB + (4 * wid + i) * 1024), 16, 0, 0); } } while (0)
#define AT_VMWAIT() asm volatile("s_waitcnt vmcnt(0)" ::: "memory")
    const int kbase0 = l31 * 512 + c * 256 + (((l31 & 14) | (half ^ (l31 & 1))) << 4);
    const int vbase0 = l31 * 128 + ((half ^ (l31 >> 4)) & 1) * 8 + (((l31 >> 1) & 7) << 4);
    const int xoff0 = (32 * rg + l31) * AT_XROW;
    f32x16 o[8];
#pragma unroll
    for (int db = 0; db < 8; ++db)
#pragma unroll
        for (int r = 0; r < 16; ++r) o[db][r] = 0.f;
    float m_ref = -__builtin_inff(), lsum = 0.f;
#define AT_BAR() do { asm volatile("" ::: "memory"); __builtin_amdgcn_s_barrier(); asm volatile("" ::: "memory"); } while (0)
#define AT_QK(hb) do { bf16x8 kf[8]; \
        _Pragma("unroll") for (int ks = 0; ks < 8; ++ks) kf[ks] = *(const LAS bf16x8*)(Kb + (kbase ^ (ks * 32)) + (hb) * 32 * 512); \
        _Pragma("unroll") for (int r = 0; r < 16; ++r) s[r] = 0.f; \
        _Pragma("unroll") for (int ks = 0; ks < 8; ++ks) s = __builtin_amdgcn_mfma_f32_32x32x16_bf16(kf[ks], qf[ks], s, 0, 0, 0); } while (0)
#define AT_SM(hb) do { \
        const bool near_ = kt >= nkt - 4; float mx; \
        if (near_) { const LAS float* tb = tbl + (kt * 64 + 32 * (hb) + 4 * half - (q0 + 32 * rg + l31) + 256); \
            _Pragma("unroll") for (int r = 0; r < 16; ++r) s[r] = s[r] * CS + tb[(r & 3) + 8 * (r >> 2)]; \
            mx = s[0]; \
            _Pragma("unroll") for (int r = 1; r < 16; ++r) mx = fmaxf(mx, s[r]); \
        } else { mx = s[0]; \
            _Pragma("unroll") for (int r = 1; r < 16; ++r) mx = fmaxf(mx, s[r]); \
            mx = mx * CS + bfar; }                                            \
        mx = fmaxf(mx, __shfl_xor(mx, 32)); \
        if (__any(mx > m_ref + 8.0f)) { \
            const float mn = fmaxf(m_ref, mx); const float al = __builtin_amdgcn_exp2f(m_ref - mn); m_ref = mn; lsum *= al; \
            _Pragma("unroll") for (int db = 0; db < 8; ++db) _Pragma("unroll") for (int r = 0; r < 16; ++r) o[db][r] *= al; } \
        float ps = 0.f; \
        if (near_) { _Pragma("unroll") for (int r = 0; r < 16; ++r) { s[r] = __builtin_amdgcn_exp2f(s[r] - m_ref); ps += s[r]; } } \
        else { const float bm_ = bfar - m_ref; _Pragma("unroll") for (int r = 0; r < 16; ++r) { s[r] = __builtin_amdgcn_exp2f(s[r] * CS + bm_); ps += s[r]; } } \
        lsum += ps; \
        { u32x4 w; \
          w.x = cvt_pk_bf16(s[0], s[1]); w.y = cvt_pk_bf16(s[2], s[3]); w.z = cvt_pk_bf16(s[4], s[5]); w.w = cvt_pk_bf16(s[6], s[7]); pf[0] = *(bf16x8*)&w; \
          w.x = cvt_pk_bf16(s[8], s[9]); w.y = cvt_pk_bf16(s[10], s[11]); w.z = cvt_pk_bf16(s[12], s[13]); w.w = cvt_pk_bf16(s[14], s[15]); pf[1] = *(bf16x8*)&w; } } while (0)
#define AT_VLOAD(hb, db_) do { int vb_ = vbase0 + (db_) * 4096; asm volatile("" : "+v"(vb_)); _Pragma("unroll") for (int s2 = 0; s2 < 2; ++s2) { \
        const u32x2 lo_ = *(const LAS u32x2*)(Vb + (vb_ ^ ((2 * (hb) + s2) * 32))), hi_ = *(const LAS u32x2*)(Vb + (vb_ ^ ((2 * (hb) + s2) * 32 + 16))); \
        vf[(db_) & 1][s2] = (u32x4){lo_.x, lo_.y, hi_.x, hi_.y}; } } while (0)
#define AT_PV(hb) do { u32x4 vf[2][2]; AT_VLOAD(hb, 0); \
        _Pragma("unroll") for (int db = 0; db < 8; ++db) { \
            if (db + 1 < 8) AT_VLOAD(hb, db + 1); \
            o[db] = __builtin_amdgcn_mfma_f32_32x32x16_bf16(*(bf16x8*)&vf[db & 1][0], pf[0], o[db], 0, 0, 0); \
            o[db] = __builtin_amdgcn_mfma_f32_32x32x16_bf16(*(bf16x8*)&vf[db & 1][1], pf[1], o[db], 0, 0, 0); } } while (0)
    AT_DMA(0, 0); AT_VMWAIT();
    __syncthreads();
    if (wid >= 4) AT_BAR();
    f32x16 s; bf16x8 pf[2];
#pragma unroll
    for (int r = 0; r < 16; ++r) s[r] = 0.f;
    pf[0] = (bf16x8){0, 0, 0, 0, 0, 0, 0, 0}; pf[1] = pf[0];
    for (int kt = 0; kt < nkt; ++kt) {
        const int cur = kt & 1;
        const bool more = kt + 1 < nkt;
        const bool active = !(kt == 2 * j + 1 && rg < 2);
        const LAS unsigned char* Kb = lds + cur * AT_STAGE; const LAS unsigned char* Vb = Kb + AT_KB;
        int kbase = kbase0; asm volatile("" : "+v"(kbase));
        if (active) { AT_QK(0); AT_SM(0); }
        AT_BAR();
        if (more) AT_DMA(kt + 1, cur ^ 1);
        if (active) { AT_PV(0); AT_QK(1); }
        AT_BAR();
        if (active) { AT_SM(1); }
        AT_VMWAIT();
        AT_BAR();
        if (active) { AT_PV(1); }
        AT_BAR();
    }
    if (wid < 4) AT_BAR();
#undef AT_BAR
#undef AT_QK
#undef AT_SM
#undef AT_VLOAD
#undef AT_PV
#undef AT_DMA
    const float ltot = lsum + __shfl_xor(lsum, 32);
    const float inv = 1.0f / ltot;
    int xo = xoff0 + 16 * half; asm volatile("" : "+v"(xo));
    if (c == 1) {
        LAS unsigned char* xrow = lds + xo;
        const float f = lam * inv;
#pragma unroll
        for (int db = 0; db < 8; ++db)
#pragma unroll
            for (int r4 = 0; r4 < 4; ++r4) {
                f32x4 v = {o[db][4 * r4] * f, o[db][4 * r4 + 1] * f, o[db][4 * r4 + 2] * f, o[db][4 * r4 + 3] * f};
                *(LAS f32x4*)(xrow + (32 * db + 8 * r4) * 4) = v;
            }
    }
    __syncthreads();
    if (c == 0) {
        asm volatile("" : "+v"(xo));
        LAS unsigned char* xrow = lds + xo;
        float ss = 0.f;
#pragma unroll
        for (int db = 0; db < 8; ++db)
#pragma unroll
            for (int r4 = 0; r4 < 4; ++r4) {
                const f32x4 x1 = *(const LAS f32x4*)(xrow + (32 * db + 8 * r4) * 4);
#pragma unroll
                for (int e = 0; e < 4; ++e) { const float x = o[db][4 * r4 + e] * inv - x1[e]; o[db][4 * r4 + e] = x; ss += x * x; }
                if ((r4 & 1) == 1) __builtin_amdgcn_sched_barrier(0);
            }
        ss += __shfl_xor(ss, 32);
        const float rms = (1.0f - LAMBDA_INIT) / sqrtf(ss * (1.0f / 256.0f) + LN_EPS);
        LDS_WAIT();
        int xb = xoff0 + 8 * half; asm volatile("" : "+v"(xb));
        LAS unsigned char* brow = lds + xb;
        int go = 16 * half; asm volatile("" : "+v"(go));
        const char* gp = (const char*)p.in[16] + go;
#pragma unroll
        for (int db = 0; db < 8; ++db)
#pragma unroll
            for (int r4 = 0; r4 < 4; ++r4) {
                const f32x4 g = *(const f32x4*)(gp + (32 * db + 8 * r4) * 4);
                u32x2 w; w.x = cvt_pk_bf16(o[db][4 * r4] * rms * g[0], o[db][4 * r4 + 1] * rms * g[1]); w.y = cvt_pk_bf16(o[db][4 * r4 + 2] * rms * g[2], o[db][4 * r4 + 3] * rms * g[3]);
                *(LAS u32x2*)(brow + (32 * db + 8 * r4) * 2) = w;
                if ((r4 & 1) == 1) __builtin_amdgcn_sched_barrier(0);
            }
    }
    __syncthreads();
    {
        int co = (tid >> 5) * AT_XROW + (tid & 31) * 16; asm volatile("" : "+v"(co));
        unsigned mo = (unsigned)(((tid >> 5) * D + (tid & 31) * 8) * 2); asm volatile("" : "+v"(mo));
        char* mb = (char*)(MIXA + (size_t)q0 * D + 2048 + head * 256);
#pragma unroll
        for (int i = 0; i < 8; ++i) {
            const u32x4 w = *(const LAS u32x4*)(lds + co + i * 16 * AT_XROW);
            *(u32x4*)(mb + mo + (size_t)i * 16 * D * 2) = w;
        }
    }
    __syncthreads();
}
__device__ __forceinline__ void attn_phase(const Params& p, LAS unsigned char* lds) {
    for (int pr = blockIdx.x; pr < 256; pr += gridDim.x) {
        const int head = pr & 7, i = pr >> 3;
        attn_item(p, lds, head, 63 - i);
        attn_item(p, lds, head, i);
    }
}

__device__ __forceinline__ void unpack8(const u32x4 v, float (&f)[8]) { f[0] = bf_lo(v.x); f[1] = bf_hi(v.x); f[2] = bf_lo(v.y); f[3] = bf_hi(v.y); f[4] = bf_lo(v.z); f[5] = bf_hi(v.z); f[6] = bf_lo(v.w); f[7] = bf_hi(v.w); }
__device__ __forceinline__ void conv_fix(const Params& p) {
    const bf16_t* GH = (const bf16_t*)(p.ws + WS_GH); const bf16_t* AH = (const bf16_t*)(p.ws + WS_AH); bf16_t* ACT = (bf16_t*)(p.ws + WS_ACT);
    const float* cw = p.in[22]; const float* cb = p.in[23];
    const int gt = blockIdx.x * 512 + threadIdx.x, ngt = gridDim.x * 512;
    constexpr int NV = DFF / 8, NSTRIP = S / 64;
    for (int it = gt; it < NV * NSTRIP; it += ngt) {
        const int cv = it % NV, st = it / NV, ch = cv * 8;
        float gm2[8], gm1[8], g0[8], g1[8], a0[8], a1[8];
#pragma unroll
        for (int e = 0; e < 8; ++e) { gm2[e] = 0.f; gm1[e] = 0.f; }
        if (st > 0) { unpack8(*(const u32x4*)(GH + (size_t)((st - 1) * 4 + 0) * DFF + ch), gm2); unpack8(*(const u32x4*)(GH + (size_t)((st - 1) * 4 + 1) * DFF + ch), gm1); }
        unpack8(*(const u32x4*)(GH + (size_t)(st * 4 + 2) * DFF + ch), g0); unpack8(*(const u32x4*)(GH + (size_t)(st * 4 + 3) * DFF + ch), g1);
        unpack8(*(const u32x4*)(AH + (size_t)(st * 2 + 0) * DFF + ch), a0); unpack8(*(const u32x4*)(AH + (size_t)(st * 2 + 1) * DFF + ch), a1);
        float r0[8], r1[8];
#pragma unroll
        for (int e = 0; e < 8; ++e) {
            const float w0 = cw[ch + e], w1 = cw[DFF + ch + e], w2 = cw[2 * DFF + ch + e], bb = cb[ch + e];
            const float c0 = bb + w0 * gm2[e] + w1 * gm1[e] + w2 * g0[e], c1 = bb + w0 * gm1[e] + w1 * g0[e] + w2 * g1[e];
            r0[e] = c0 * sigmoidf_(c0) * a0[e]; r1[e] = c1 * sigmoidf_(c1) * a1[e];
        }
        u32x4 w; w.x = cvt_pk_bf16(r0[0], r0[1]); w.y = cvt_pk_bf16(r0[2], r0[3]); w.z = cvt_pk_bf16(r0[4], r0[5]); w.w = cvt_pk_bf16(r0[6], r0[7]);
        *(u32x4*)(ACT + (size_t)(st * 64) * DFF + ch) = w;
        w.x = cvt_pk_bf16(r1[0], r1[1]); w.y = cvt_pk_bf16(r1[2], r1[3]); w.z = cvt_pk_bf16(r1[4], r1[5]); w.w = cvt_pk_bf16(r1[6], r1[7]);
        *(u32x4*)(ACT + (size_t)(st * 64 + 1) * DFF + ch) = w;
    }
}

#define XB_TMO      128
#define XB_XCNT(j)  (256  + 64 * (j))
#define XB_XSUB(j)  (1280 + 64 * (j))
#define XB_XGEN(j)  (2304 + 64 * (j))
#define XB_TOP      3328
#define XB_TOPGEN   3392
#define XCD_BAR_WORDS 3456
#define XB_SPIN_CAP (1u << 18)

__device__ __forceinline__ unsigned xb_ld(unsigned* p)              { return __hip_atomic_load(p, __ATOMIC_RELAXED, __HIP_MEMORY_SCOPE_AGENT); }
__device__ __forceinline__ unsigned xb_add(unsigned* p, unsigned v) { return __hip_atomic_fetch_add(p, v, __ATOMIC_RELAXED, __HIP_MEMORY_SCOPE_AGENT); }
__device__ __forceinline__ unsigned xb_xcc_id() { return (unsigned)__builtin_amdgcn_s_getreg((3 << 11) | 20) & 0xFu; }
#define XB_SPIN(cond, bar) do { unsigned _sp = 0; while (cond) { __builtin_amdgcn_s_sleep(1); \
    if ((++_sp & 255u) == 0u) { if (xb_ld(&(bar)[XB_TMO])) break; if (_sp > XB_SPIN_CAP) { atomicAdd(&(bar)[XB_TMO], 1u); break; } } } } while (0)

struct XcdBarrier {
    unsigned* bar; unsigned x;
    volatile LAS unsigned* st;
};

__device__ __forceinline__ XcdBarrier xcd_barrier_post(unsigned* bar, volatile LAS unsigned* st) {
    XcdBarrier b; b.bar = bar; b.x = xb_xcc_id(); b.st = st;
    if (threadIdx.x == 0) (void)xb_add(&bar[XB_XCNT(b.x)], 1u);
    return b;
}
__device__ __forceinline__ void xcd_barrier_complete(unsigned* bar, unsigned x, unsigned& nloc, unsigned& nx) {
    const unsigned G = gridDim.x * gridDim.y * gridDim.z;
    unsigned sum, cnt, mine, sp = 0u;
    for (;;) {
        sum = 0u; cnt = 0u; mine = 0u;
#pragma unroll
        for (unsigned j = 0; j < 16; ++j) { const unsigned c = xb_ld(&bar[XB_XCNT(j)]); sum += c; cnt += (c > 0u) ? 1u : 0u; mine = (j == x) ? c : mine; }
        if (sum == G) break;
        __builtin_amdgcn_s_sleep(1);
        if ((++sp & 255u) == 0u) { if (xb_ld(&bar[XB_TMO])) break; if (sp > XB_SPIN_CAP) { atomicAdd(&bar[XB_TMO], 1u); break; } }
    }
    nloc = mine > 0u ? mine : 1u; nx = cnt > 0u ? cnt : 1u;
}

__device__ __forceinline__ void xcd_barrier(const XcdBarrier& b) {
    asm volatile("s_waitcnt vmcnt(0)" ::: "memory");
    __syncthreads();
    if (threadIdx.x == 0) {
        unsigned* bar = b.bar;
        __builtin_amdgcn_s_waitcnt(0);
        unsigned nloc = b.st[0], nx = b.st[1];
        if (nloc == 0u) { xcd_barrier_complete(bar, b.x, nloc, nx); b.st[0] = nloc; b.st[1] = nx; }
        const unsigned old = xb_add(&bar[XB_XSUB(b.x)], 1u);
        const unsigned gen = old / nloc;
        if (old + 1u == (gen + 1u) * nloc) {
            __builtin_amdgcn_fence(__ATOMIC_RELEASE, "agent");
            asm volatile("s_waitcnt vmcnt(0)" ::: "memory");
            const unsigned og = xb_add(&bar[XB_TOP], 1u);
            const unsigned tg = og / nx;
            if (og + 1u == (tg + 1u) * nx) xb_add(&bar[XB_TOPGEN], 1u);
            else XB_SPIN(xb_ld(&bar[XB_TOPGEN]) == tg, bar);
            __builtin_amdgcn_fence(__ATOMIC_ACQUIRE, "agent");
            xb_add(&bar[XB_XGEN(b.x)], 1u);
            asm volatile("s_waitcnt vmcnt(0)" ::: "memory");
        } else {
            XB_SPIN(xb_ld(&bar[XB_XGEN(b.x)]) == gen, bar);
            __builtin_amdgcn_fence(__ATOMIC_ACQUIRE, "agent");
            asm volatile("s_waitcnt vmcnt(0)" ::: "memory");
        }
    }
    __syncthreads();
}

#ifndef GEMM_SP2
#define GEMM_SP2 true
#endif
#ifndef GEMM_ALIGN_EPI
#define GEMM_ALIGN_EPI true
#endif
template <class Epi> __device__ __forceinline__ void run_gemm(LAS unsigned char* lds, const bf16_t* A, const bf16_t* Bt, int M, int N, int K, const Epi& E) {
    pg8::Gemm g{A, Bt, M, N, K}; pg8::StaticOrder So; So.init(M, N, (int)gridDim.x, (int)blockIdx.x);
    pg8::gemm_phase<Epi, pg8::StaticOrder, GEMM_ALIGN_EPI, GEMM_SP2>(lds, g, So, E);
}

__global__ void __launch_bounds__(512, 2) mega(Params p) {
    extern __shared__ __attribute__((aligned(16))) unsigned char shm[];
    LAS unsigned char* lds = (LAS unsigned char*)shm;
    cg::grid_group grid = cg::this_grid();
    unsigned char* ws = p.ws;
#ifndef PHMASK
#define PHMASK 0x7ff
#endif
#define IN(k) ((((PHMASK) >> (k)) & 1) && p.ph_lo <= (k) && (k) < p.ph_hi)
#define SEAM(k) do { if (IN(k) && IN((k) + 1)) xcd_barrier(xbar); } while (0)
    if (threadIdx.x < 4) ((volatile LAS unsigned*)(lds + LDS_XB))[threadIdx.x] = 0u;
    __syncthreads();
    if (IN(0)) phase0(p, lds);
    if (IN(0) && IN(1)) grid.sync();
    XcdBarrier xbar = xcd_barrier_post((unsigned*)(ws + WS_CTL + CTL_BAR), (volatile LAS unsigned*)(lds + LDS_XB));
    if (IN(1)) {
        run_gemm(lds, (const bf16_t*)(ws + WS_XB), (const bf16_t*)(ws + WS_WIN), S, PW, D, EpiBf16Plain{(bf16_t*)(ws + WS_P), PW});
        run_gemm(lds, (const bf16_t*)(ws + WS_WIN) + (size_t)PW * D, (const bf16_t*)(ws + WS_XB), 2048, S, D, EpiBf16PlainT<true>{(bf16_t*)(ws + WS_VT), S});
    }
    SEAM(1);
    if (IN(2)) ssm_pass<1>(p, lds);
    SEAM(2);
    if (IN(3)) {
#ifndef NO_ATT
        attn_phase(p, lds);
#endif
#ifndef NO_SSM2
        ssm_pass<2>(p, lds);
#endif
        __syncthreads(); }
    SEAM(3);
    if (IN(4)) run_gemm(lds, (const bf16_t*)(ws + WS_YG), (const bf16_t*)(ws + WS_WGLU), S, 2048, 2048, EpiGlu{(bf16_t*)(ws + WS_MIXA), D, (const bf16_t*)(ws + WS_YG), p.in[11]});
    SEAM(4);
    if (IN(5)) run_gemm(lds, (const bf16_t*)(ws + WS_MIXA), (const bf16_t*)(ws + WS_WOUT), S, D, D, EpiResX{(bf16_t*)(ws + WS_H1B), (const bf16_t*)(ws + WS_XB), D});
    SEAM(5);
    if (IN(6)) ln_rows<false>((bf16_t*)(ws + WS_H1B), nullptr, p.in[19], p.in[20]);
    SEAM(6);
    if (IN(7)) run_gemm(lds, (const bf16_t*)(ws + WS_H1B), (const bf16_t*)(ws + WS_WUP), S, UPW, D, EpiConvGate{(bf16_t*)(ws + WS_ACT), (bf16_t*)(ws + WS_GH), (bf16_t*)(ws + WS_AH), p.in[22], p.in[23]});
    SEAM(7);
    if (IN(8)) conv_fix(p);
    SEAM(8);
    if (IN(9)) run_gemm(lds, (const bf16_t*)(ws + WS_ACT), (const bf16_t*)(ws + WS_WDOWN), S, D, DFF, EpiResB{(bf16_t*)(ws + WS_R1), (const bf16_t*)(ws + WS_H1B), D});
    SEAM(9);
    if (IN(10)) ln_rows<true>((bf16_t*)(ws + WS_R1), p.out, p.in[25], p.in[26]);
#undef IN
#undef SEAM
}
}

extern "C" void kernel_launch(void* const* d_in, const int* in_sizes, int n_in, void* d_out, int out_size, void* d_ws, size_t ws_size, hipStream_t stream) {
    static int grid = 0;
    if (grid == 0) {
        if (n_in != 27 || ws_size < mk::WS_END) { fprintf(stderr, "kernel_launch: unexpected inputs (n_in %d, ws %zu)\n", n_in, ws_size); grid = -1; return; }
        int dev = 0, cus = 0, per_cu = 0;
        (void)hipGetDevice(&dev); (void)hipDeviceGetAttribute(&cus, hipDeviceAttributeMultiprocessorCount, dev);
        if (hipFuncSetAttribute((const void*)mk::mega, hipFuncAttributeMaxDynamicSharedMemorySize, mk::LDS_BYTES) != hipSuccess) { fprintf(stderr, "kernel_launch: hipFuncSetAttribute failed\n"); grid = -1; return; }
        if (hipOccupancyMaxActiveBlocksPerMultiprocessor(&per_cu, (const void*)mk::mega, 512, mk::LDS_BYTES) != hipSuccess || per_cu < 1) { fprintf(stderr, "kernel_launch: occupancy query says %d\n", per_cu); per_cu = 1; }
        (void)hipGetLastError();
        grid = cus * 1;
        if (grid <= 0) grid = 256;
    }
    if (grid < 0) return;
    mk::Params p{};
    for (int i = 0; i < 27; ++i) p.in[i] = (const float*)d_in[i];
    p.out = (float*)d_out; p.ws = (unsigned char*)d_ws; p.ph_lo = 0; p.ph_hi = 11;
    void* args[] = {&p};
    const hipError_t e = hipLaunchCooperativeKernel((const void*)mk::mega, dim3(grid), dim3(512), args, mk::LDS_BYTES, stream);
    if (e != hipSuccess) fprintf(stderr, "kernel_launch: cooperative launch failed: %s (grid %d)\n", hipGetErrorString(e), grid);
}
```

```cpp
#include <hip/hip_runtime.h>
#include <hip/hip_cooperative_groups.h>
#include <cstdio>
namespace cg = cooperative_groups;
#include <hip/hip_runtime.h>
namespace pg8 {
#define PG8_LAS __attribute__((address_space(3)))
typedef unsigned short bf16_t;
typedef short bf16x8 __attribute__((ext_vector_type(8)));
typedef float f32x4 __attribute__((ext_vector_type(4)));
typedef unsigned u32x4 __attribute__((ext_vector_type(4)));
constexpr int BM = 256, BK = 64, HALF = 128, HTB = HALF * BK * 2  , STAGE_BYTES = 8 * HTB, NXCD = 8, WGM = 8;

__host__ __device__ __forceinline__ int lds_byte(int r, int c) { const int st = (r >> 4) * 2 + (c >> 5), rr = r & 15, cc = c & 31, ob = rr * 64 + cc * 2; return st * 1024 + (ob ^ (((ob >> 9) & 1) << 5)); }
__host__ __device__ __forceinline__ void stage_rc(int b, int& R, int& C) { const int st = b / 1024, sb = b % 1024, swz = sb ^ (((sb >> 9) & 1) << 5); R = (st >> 1) * 16 + swz / 64; C = (st & 1) * 32 + (swz % 64) / 2; }
__host__ __device__ __forceinline__ int perm32(int rho) { const int n = rho >> 4, i = rho & 15; return 8 * (i >> 2) + 4 * n + (i & 3); }

struct Unit { int pm, pn; };
struct Gemm { const bf16_t* A; const bf16_t* Bt; int M, N, K; };

struct StaticOrder {
    int nM, nN, nwg, G, c;
    __host__ __device__ void init(int M, int N, int G_, int c_) { nM = M / BM; nN = N / BM; nwg = nM * nN; G = G_; c = c_; }
    __host__ __device__ bool next(int i, Unit& u) const {
        const long L = (long)i * G + c; if (L >= nwg) return false;
        int wgid = (int)L; { const int q = nwg / NXCD, r = nwg % NXCD, xcd = wgid % NXCD, off = wgid / NXCD; wgid = (xcd < r ? xcd * (q + 1) : r * (q + 1) + (xcd - r) * q) + off; }
        const int nig = WGM * nN, gid = wgid / nig, fm = gid * WGM, gsz = (nM - fm) < WGM ? (nM - fm) : WGM;
        u.pm = fm + ((wgid % nig) % gsz); u.pn = (wgid % nig) / gsz; return true;
    }
    __device__ __forceinline__ void a_ready(const Unit&) const {}
    __device__ __forceinline__ void done(const Unit&) const {}
};
__device__ __forceinline__ unsigned cvt_pk_bf16(float lo, float hi) { unsigned r; asm volatile("v_cvt_pk_bf16_f32 %0, %1, %2" : "=v"(r) : "v"(lo), "v"(hi)); return r; }
template <class Epi, class Sched, bool ALIGN_EPI = false, bool SP2 = false>
__device__ __forceinline__ void gemm_phase(PG8_LAS unsigned char* lds, const Gemm g, const Sched& S, const Epi& E) {
    const int tid = threadIdx.x, wid = __builtin_amdgcn_readfirstlane(tid >> 6), lane = tid & 63, wr = wid >> 2, wc = wid & 3, fr = lane & 15, fq = lane >> 4;
    const int K = g.K, nt = K / BK;
    unsigned voffA[2], voffB[2];
#pragma unroll
    for (int i = 0; i < 2; ++i) { int R, C; stage_rc(tid * 16 + i * 8192, R, C); const int Rb = Epi::PERM ? ((R & ~31) + perm32(R & 31)) : R;
        voffA[i] = (unsigned)(R * K + C) * 2u; voffB[i] = (unsigned)(Rb * K + C) * 2u; }
    const size_t kstep = (size_t)(BK * 2);
    const size_t hstep = (size_t)HALF * K * 2;
    const size_t tstep = 2 * hstep;
    const unsigned ldsw = (unsigned)wid * 1024u;
    const int aoff = lds_byte(wr * 64 + fr, fq * 8), boff = lds_byte(wc * 32 + fr, fq * 8);
#define PG8_SA(b, h) (((b) * 2 + (h)) * HTB)
#define PG8_SB(b, h) ((4 + (b) * 2 + (h)) * HTB)
#define PG8_STAGE(bufoff, gbase, voff) do { _Pragma("unroll") for (int _i = 0; _i < 2; ++_i) \
        __builtin_amdgcn_global_load_lds((const unsigned*)((const char*)(gbase) + (voff)[_i]), (PG8_LAS unsigned*)(lds + (bufoff) + ldsw + _i * 8192), 16, 0, 0); } while (0)
#define PG8_LDA(dst, b, h) do { _Pragma("unroll") for (int m = 0; m < 4; ++m) _Pragma("unroll") for (int k = 0; k < 2; ++k) dst[m][k] = *(const PG8_LAS bf16x8*)(lds + PG8_SA(b, h) + aoff + m * 2048 + k * 1024); } while (0)
#define PG8_LDB(dst, b, h) do { _Pragma("unroll") for (int n = 0; n < 2; ++n) _Pragma("unroll") for (int k = 0; k < 2; ++k) dst[n][k] = *(const PG8_LAS bf16x8*)(lds + PG8_SB(b, h) + boff + n * 2048 + k * 1024); } while (0)
#define PG8_MMA(ai, bj, At, Bt) do { __builtin_amdgcn_s_setprio(1); _Pragma("unroll") for (int m = 0; m < 4; ++m) _Pragma("unroll") for (int n = 0; n < 2; ++n) _Pragma("unroll") for (int k = 0; k < 2; ++k) \
        acc[ai][bj][m][n] = __builtin_amdgcn_mfma_f32_16x16x32_bf16(Bt[n][k], At[m][k], acc[ai][bj][m][n], 0, 0, 0); __builtin_amdgcn_s_setprio(0); } while (0)
#define PG8_WAIT_V(n) asm volatile("s_waitcnt vmcnt(" #n ")" ::: "memory")
#define PG8_WAIT_L(n) asm volatile("s_waitcnt lgkmcnt(" #n ")" ::: "memory")
#define PG8_BAR __builtin_amdgcn_s_barrier()
#define PG8_SCHED __builtin_amdgcn_sched_barrier(0)
    Unit cur, nxt; int ui = 0;
    if (!S.next(0, cur)) return;
    f32x4 acc[2][2][4][2];
#pragma unroll
    for (int a = 0; a < 2; ++a)
#pragma unroll
        for (int b = 0; b < 2; ++b)
#pragma unroll
            for (int m = 0; m < 4; ++m)
#pragma unroll
                for (int n = 0; n < 2; ++n) acc[a][b][m][n] = (f32x4){0.f, 0.f, 0.f, 0.f};
    bf16x8 At[4][2], B0[2][2], B1[2][2];
    const char* cA = (const char*)g.A + (size_t)cur.pm * tstep; const char* cB = (const char*)g.Bt + (size_t)cur.pn * tstep;
    S.a_ready(cur);
    if constexpr (SP2) {
        PG8_STAGE(PG8_SB(0, 0), cB, voffB); PG8_STAGE(PG8_SB(0, 1), cB + hstep, voffB); PG8_STAGE(PG8_SA(0, 0), cA, voffA); PG8_STAGE(PG8_SA(0, 1), cA + hstep, voffA);
        if (wr == 1) PG8_BAR;
        PG8_WAIT_V(2); PG8_BAR;
        PG8_STAGE(PG8_SB(1, 0), cB + kstep, voffB); PG8_STAGE(PG8_SA(1, 0), cA + kstep, voffA); PG8_STAGE(PG8_SB(1, 1), cB + hstep + kstep, voffB);
        PG8_WAIT_V(6); PG8_BAR;
    } else {
        PG8_STAGE(PG8_SB(0, 0), cB, voffB); PG8_STAGE(PG8_SA(0, 0), cA, voffA); PG8_STAGE(PG8_SB(0, 1), cB + hstep, voffB); PG8_STAGE(PG8_SA(0, 1), cA + hstep, voffA);
        if (wr == 1) PG8_BAR;
        PG8_WAIT_V(4); PG8_BAR;
        PG8_STAGE(PG8_SB(1, 0), cB + kstep, voffB); PG8_STAGE(PG8_SA(1, 0), cA + kstep, voffA); PG8_STAGE(PG8_SB(1, 1), cB + hstep + kstep, voffB);
        PG8_WAIT_V(6); PG8_BAR;
    }
    for (;;) {
        const bool has_next = S.next(ui + 1, nxt);
        const char* nA = has_next ? (const char*)g.A + (size_t)nxt.pm * tstep : cA; const char* nB = has_next ? (const char*)g.Bt + (size_t)nxt.pn * tstep : cB;
        for (int t = 0; t < nt; t += 2) {
            const bool last = (t == nt - 2);
            const char* a1 = cA + (size_t)(t + 1) * kstep;
            const char* a2 = last ? nA : cA + (size_t)(t + 2) * kstep; const char* b2 = last ? nB : cB + (size_t)(t + 2) * kstep;
            const char* a3 = a2 + kstep; const char* b3 = b2 + kstep;
            if (last && has_next) S.a_ready(nxt);
            if constexpr (SP2) {
            PG8_LDB(B0, 0, 0); PG8_LDB(B1, 0, 1); PG8_SCHED; PG8_LDA(At, 0, 0); PG8_STAGE(PG8_SA(1, 1), a1 + hstep, voffA);
            PG8_WAIT_V(8); PG8_WAIT_L(0); PG8_BAR; PG8_MMA(0, 0, At, B0); PG8_MMA(0, 1, At, B1); PG8_BAR; PG8_SCHED;
            PG8_LDA(At, 0, 1); PG8_STAGE(PG8_SB(0, 0), b2, voffB); PG8_STAGE(PG8_SB(0, 1), b2 + hstep, voffB); PG8_STAGE(PG8_SA(0, 0), a2, voffA);
            PG8_WAIT_V(8); PG8_WAIT_L(0); PG8_BAR; PG8_MMA(1, 0, At, B0); PG8_MMA(1, 1, At, B1); PG8_BAR; PG8_SCHED;
            PG8_LDB(B0, 1, 0); PG8_LDB(B1, 1, 1); PG8_SCHED; PG8_LDA(At, 1, 0); PG8_STAGE(PG8_SA(0, 1), a2 + hstep, voffA);
            PG8_WAIT_V(8); PG8_WAIT_L(0); PG8_BAR; PG8_MMA(0, 0, At, B0); PG8_MMA(0, 1, At, B1); PG8_BAR; PG8_SCHED;
            PG8_LDA(At, 1, 1); PG8_STAGE(PG8_SB(1, 0), b3, voffB); PG8_STAGE(PG8_SB(1, 1), b3 + hstep, voffB); PG8_STAGE(PG8_SA(1, 0), a3, voffA);
            PG8_WAIT_V(8); PG8_WAIT_L(0); PG8_BAR; PG8_MMA(1, 0, At, B0); PG8_MMA(1, 1, At, B1); PG8_BAR; PG8_SCHED;
            } else {
            PG8_LDB(B0, 0, 0); PG8_SCHED; PG8_LDA(At, 0, 0); PG8_STAGE(PG8_SA(1, 1), a1 + hstep, voffA);
            PG8_WAIT_L(8); PG8_BAR; PG8_WAIT_L(0); PG8_MMA(0, 0, At, B0); PG8_BAR; PG8_SCHED;
            PG8_LDB(B1, 0, 1); PG8_STAGE(PG8_SB(0, 0), b2, voffB);
            PG8_BAR; PG8_WAIT_L(0); PG8_MMA(0, 1, At, B1); PG8_BAR;
            PG8_LDA(At, 0, 1); PG8_STAGE(PG8_SA(0, 0), a2, voffA);
            PG8_BAR; PG8_WAIT_L(0); PG8_MMA(1, 0, At, B0); PG8_BAR; PG8_SCHED;
            PG8_STAGE(PG8_SB(0, 1), b2 + hstep, voffB);
            PG8_WAIT_V(6); PG8_BAR; PG8_MMA(1, 1, At, B1); PG8_BAR;
            PG8_LDB(B0, 1, 0); PG8_SCHED; PG8_LDA(At, 1, 0); PG8_STAGE(PG8_SA(0, 1), a2 + hstep, voffA);
            PG8_WAIT_L(8); PG8_BAR; PG8_WAIT_L(0); PG8_MMA(0, 0, At, B0); PG8_BAR; PG8_SCHED;
            PG8_LDB(B1, 1, 1); PG8_STAGE(PG8_SB(1, 0), b3, voffB);
            PG8_BAR; PG8_WAIT_L(0); PG8_MMA(0, 1, At, B1); PG8_BAR;
            PG8_LDA(At, 1, 1); PG8_STAGE(PG8_SA(1, 0), a3, voffA);
            PG8_BAR; PG8_WAIT_L(0); PG8_MMA(1, 0, At, B0); PG8_BAR; PG8_SCHED;
            PG8_STAGE(PG8_SB(1, 1), b3 + hstep, voffB);
            PG8_WAIT_V(6); PG8_BAR; PG8_MMA(1, 1, At, B1); PG8_BAR;
            }
        }
        if constexpr (ALIGN_EPI) { if (wr == 0) PG8_BAR; }
        if constexpr (!Epi::AFTER_DRAIN) { E(acc, cur, wr, wc, fr, fq); S.done(cur); }
        if (!has_next) break;
#pragma unroll
        for (int a = 0; a < 2; ++a)
#pragma unroll
            for (int b = 0; b < 2; ++b)
#pragma unroll
                for (int m = 0; m < 4; ++m)
#pragma unroll
                    for (int n = 0; n < 2; ++n) acc[a][b][m][n] = (f32x4){0.f, 0.f, 0.f, 0.f};
        cur = nxt; cA = nA; cB = nB; ++ui;
        if constexpr (ALIGN_EPI) { if (wr == 1) PG8_BAR; }
    }
    PG8_WAIT_V(0);
    if constexpr (!ALIGN_EPI) { if (wr == 0) PG8_BAR; }
    PG8_BAR;
    if constexpr (Epi::AFTER_DRAIN) { E.fused(acc, cur, wr, wc, fr, fq, lds, wid, lane); S.done(cur); }
#undef PG8_SA
#undef PG8_SB
#undef PG8_STAGE
#undef PG8_LDA
#undef PG8_LDB
#undef PG8_MMA
#undef PG8_WAIT_V
#undef PG8_WAIT_L
#undef PG8_BAR
#undef PG8_SCHED
}
}


namespace mk {
using pg8::bf16_t; using pg8::bf16x8; using pg8::f32x4; using pg8::u32x4; using pg8::cvt_pk_bf16; using pg8::Unit;
typedef float f32x16 __attribute__((ext_vector_type(16)));
typedef unsigned u32x2 __attribute__((ext_vector_type(2)));
#define LAS __attribute__((address_space(3)))
#define LDS_WAIT() asm volatile("s_waitcnt lgkmcnt(0)" ::: "memory")

constexpr int S = 8192, D = 4096, NG = 128, DFF = 11008, UPW = 22016, PW = 6144;
constexpr int NC = 16, LC = 512;
constexpr float ALPHA = 1.189207115002721f;
constexpr float LN_EPS = 1e-5f;
constexpr float LAMBDA_INIT = 0.2f;
constexpr float LOG2E = 1.4426950408889634f;
constexpr int LDS_BYTES = 147456, LDS_XB = LDS_BYTES - 16;
constexpr size_t CTL_BAR = 4096;

constexpr size_t MiB = 1ull << 20;
constexpr size_t WS_CTL = 0, WS_XB = 1 * MiB, WS_WIN = 65 * MiB, WS_P = 129 * MiB, WS_VT = 225 * MiB, WS_YG = 257 * MiB, WS_MIXA = 289 * MiB,
                 WS_GH = 1 * MiB, WS_AH = 17 * MiB  , WS_WGLU = 353 * MiB, WS_WOUT = 361 * MiB, WS_WUP = 393 * MiB, WS_WDOWN = 565 * MiB,
                 WS_R1 = 651 * MiB, WS_H1B = 779 * MiB, WS_ACT = 843 * MiB, WS_SSMA = 1015 * MiB, WS_SSMAL = WS_SSMA + 65536, WS_SSMBB = WS_SSMAL + 65536,
                 WS_SSME = 1016 * MiB, WS_END = 1017 * MiB;

struct Params { const float* in[27]; float* out; unsigned char* ws; int ph_lo, ph_hi; };

__device__ __forceinline__ float wave_sum(float v) {
#pragma unroll
    for (int o = 1; o < 64; o <<= 1) v += __shfl_xor(v, o);
    return v;
}
__device__ __forceinline__ float bf_lo(unsigned w) { return __uint_as_float(w << 16); }
__device__ __forceinline__ float bf_hi(unsigned w) { return __uint_as_float(w & 0xffff0000u); }
__device__ __forceinline__ float gelu_tanh(float y) {
    const float inner = y * (1.0f + 0.044715f * y * y);
    const float e = __builtin_amdgcn_exp2f(inner * (-2.0f * 0.7978845608028654f * LOG2E));
    return y * __builtin_amdgcn_rcpf(1.0f + e);
}
__device__ __forceinline__ float sigmoidf_(float z) { return __builtin_amdgcn_rcpf(1.0f + __builtin_amdgcn_exp2f(-z * LOG2E)); }

template <int MODE> __device__ __forceinline__ int rowmap(int n) {
    if (MODE == 0) return n;
    const int isg = n >= DFF ? 1 : 0; const int c = isg ? n - DFF : n; return 256 * (c >> 7) + 128 * isg + (c & 127);
}
template <int MODE, bool NTST> __device__ __forceinline__ void transpose_tile(const float* __restrict__ W, int K, int N, bf16_t* __restrict__ WT, LAS float* scr, int item, int lane) {
    const int nblk = N / 64;
    const int kb = item / nblk, nb = item % nblk, k0 = kb * 64, n0 = nb * 64;
#pragma unroll 8
    for (int i = 0; i < 64; ++i) scr[i * 65 + lane] = __builtin_nontemporal_load(W + (size_t)(k0 + i) * N + n0 + lane);
    LDS_WAIT();
    const int c = lane & 7;
#pragma unroll
    for (int j = 0; j < 8; ++j) {
        const int n = (lane >> 3) + 8 * j; const LAS float* s = scr + (8 * c) * 65 + n;
        u32x4 o; o.x = cvt_pk_bf16(s[0], s[65]); o.y = cvt_pk_bf16(s[130], s[195]); o.z = cvt_pk_bf16(s[260], s[325]); o.w = cvt_pk_bf16(s[390], s[455]);
        if (NTST) __builtin_nontemporal_store(o, (u32x4*)(WT + (size_t)rowmap<MODE>(n0 + n) * K + k0 + 8 * c));
        else *(u32x4*)(WT + (size_t)rowmap<MODE>(n0 + n) * K + k0 + 8 * c) = o;
    }
    LDS_WAIT();
}

__device__ __forceinline__ void phase0(const Params& p, LAS unsigned char* lds) {
    const int tid = threadIdx.x, lane = tid & 63, wid = tid >> 6;
    const int gw = blockIdx.x * 8 + wid, nw = gridDim.x * 8;
    const int gt = blockIdx.x * 512 + tid, ngt = gridDim.x * 512;
    unsigned char* ws = p.ws;
    {
        const f32x4* x4 = (const f32x4*)p.in[0]; u32x4* xb = (u32x4*)(ws + WS_XB);
        const int n8 = S * D / 8;
        for (int i = gt; i < n8; i += ngt) {
            const f32x4 a = __builtin_nontemporal_load(x4 + 2 * i), b = __builtin_nontemporal_load(x4 + 2 * i + 1);
            u32x4 w; w.x = cvt_pk_bf16(a[0], a[1]); w.y = cvt_pk_bf16(a[2], a[3]); w.z = cvt_pk_bf16(b[0], b[1]); w.w = cvt_pk_bf16(b[2], b[3]);
            xb[i] = w;
        }
    }
    for (int i = (int)blockIdx.x + (int)gridDim.x * tid; i < NG * 64; i += (int)gridDim.x * 512) {
        const int g = i >> 6, n = i & 63;
        const double step = exp((double)p.in[2][g]);
        const double lr = (double)p.in[3][i], li = (double)p.in[4][i];
        const double mag = exp(lr * step); double sn, cs; sincos(li * step, &sn, &cs);
        const double are = mag * cs, aim = mag * sn;
        const double den = lr * lr + li * li, nr = are - 1.0, ni = aim;
        const double zre = (nr * lr + ni * li) / den, zim = (ni * lr - nr * li) / den;
        float* A = (float*)(ws + WS_SSMA); float* AL = (float*)(ws + WS_SSMAL); bf16_t* BB = (bf16_t*)(ws + WS_SSMBB);
        const float are_f = (float)are, aim_f = (float)aim;
        A[2 * i] = are_f; A[2 * i + 1] = aim_f;
        double pr = (double)are_f, pi = (double)aim_f;
#pragma unroll
        for (int s = 0; s < 9; ++s) { const double t = pr * pr - pi * pi; pi = 2.0 * pr * pi; pr = t; }
        AL[2 * i] = (float)pr; AL[2 * i + 1] = (float)pi;
        const float* bre = p.in[5] + (size_t)i * 16; const float* bim = p.in[6] + (size_t)i * 16;
        unsigned wre[8], wim[8];
#pragma unroll
        for (int h = 0; h < 16; h += 2) {
            const double br0 = bre[h], bi0 = bim[h], br1 = bre[h + 1], bi1 = bim[h + 1];
            wre[h >> 1] = cvt_pk_bf16((float)(zre * br0 - zim * bi0), (float)(zre * br1 - zim * bi1));
            wim[h >> 1] = cvt_pk_bf16((float)(zre * bi0 + zim * br0), (float)(zre * bi1 + zim * br1));
        }
        u32x4* dre = (u32x4*)(BB + ((size_t)g * 128 + n) * 16); u32x4* dim = (u32x4*)(BB + ((size_t)g * 128 + 64 + n) * 16);
        dre[0] = (u32x4){wre[0], wre[1], wre[2], wre[3]}; dre[1] = (u32x4){wre[4], wre[5], wre[6], wre[7]};
        dim[0] = (u32x4){wim[0], wim[1], wim[2], wim[3]}; dim[1] = (u32x4){wim[4], wim[5], wim[6], wim[7]};
    }
    if (blockIdx.x == 0) { unsigned* bw = (unsigned*)(ws + WS_CTL + CTL_BAR); for (int i = tid; i < 3456; i += 512) bw[i] = 0u; }
    if (blockIdx.x == 0 && wid == 0) {
        float s1 = p.in[12][lane] * p.in[13][lane] + p.in[12][lane + 64] * p.in[13][lane + 64];
        float s2 = p.in[14][lane] * p.in[15][lane] + p.in[14][lane + 64] * p.in[15][lane + 64];
        s1 = wave_sum(s1); s2 = wave_sum(s2);
        if (lane == 0) ((float*)(ws + WS_CTL))[0] = expf(s1) - expf(s2) + LAMBDA_INIT;
    }
    LAS float* scr = (LAS float*)(lds + wid * (64 * 65 * 4));
    constexpr int T_IN = (D / 64) * (8192 / 64), T_GLU = 32 * 32, T_OUT = 64 * 64, T_UP = (D / 64) * (UPW / 64), T_DN = (DFF / 64) * (D / 64);
    constexpr int E_IN = T_IN, E_GLU = E_IN + T_GLU, E_OUT = E_GLU + T_OUT, E_UP = E_OUT + T_UP, E_DN = E_UP + T_DN;
    for (int it = gw; it < E_DN; it += nw) {
        if (it < E_IN) transpose_tile<0, false>(p.in[1], D, 8192, (bf16_t*)(ws + WS_WIN), scr, it, lane);
        else if (it < E_GLU) transpose_tile<0, true>(p.in[10], 2048, 2048, (bf16_t*)(ws + WS_WGLU), scr, it - E_IN, lane);
        else if (it < E_OUT) transpose_tile<0, true>(p.in[18], D, D, (bf16_t*)(ws + WS_WOUT), scr, it - E_GLU, lane);
        else if (it < E_UP) transpose_tile<1, true>(p.in[21], D, UPW, (bf16_t*)(ws + WS_WUP), scr, it - E_OUT, lane);
        else transpose_tile<0, true>(p.in[24], DFF, D, (bf16_t*)(ws + WS_WDOWN), scr, it - E_UP, lane);
    }
}

template <bool SWAP16> struct EpiBf16PlainT {
    static constexpr bool PERM = true, AFTER_DRAIN = false;
    bf16_t* O; int ldc;
    __device__ __forceinline__ void operator()(const f32x4 (&acc)[2][2][4][2], const Unit& u, int wr, int wc, int fr, int fq) const {
        const int row0 = u.pm * 256 + wr * 64 + fr, col0 = u.pn * 256 + wc * 32 + 8 * fq;
#pragma unroll
        for (int ai = 0; ai < 2; ++ai)
#pragma unroll
            for (int m = 0; m < 4; ++m) { bf16_t* rowp = O + (size_t)(row0 + ai * 128 + m * 16) * ldc + col0;
#pragma unroll
                for (int bj = 0; bj < 2; ++bj) { const f32x4 v0 = acc[ai][bj][m][0], v1 = acc[ai][bj][m][1];
                    u32x4 w; w.x = cvt_pk_bf16(v0[0], v0[1]); w.y = cvt_pk_bf16(v0[2], v0[3]); w.z = cvt_pk_bf16(v1[0], v1[1]); w.w = cvt_pk_bf16(v1[2], v1[3]);
                    if (SWAP16 && (m & 1)) w = (u32x4){w.z, w.w, w.x, w.y};
                    *(u32x4*)(rowp + bj * 128) = w; } }
    }
};
typedef EpiBf16PlainT<false> EpiBf16Plain;
struct EpiGlu {
    static constexpr bool PERM = true, AFTER_DRAIN = false;
    bf16_t* O; int ldo; const bf16_t* YG; const float* bias;
    __device__ __forceinline__ void operator()(const f32x4 (&acc)[2][2][4][2], const Unit& u, int wr, int wc, int fr, int fq) const {
        const int row0 = u.pm * 256 + wr * 64 + fr, col0 = u.pn * 256 + wc * 32 + 8 * fq;
#pragma unroll
        for (int bj = 0; bj < 2; ++bj) {
            const f32x4 b0 = *(const f32x4*)(bias + col0 + bj * 128), b1 = *(const f32x4*)(bias + col0 + bj * 128 + 4);
#pragma unroll
            for (int ai = 0; ai < 2; ++ai)
#pragma unroll
                for (int m = 0; m < 4; ++m) { const size_t row = (size_t)(row0 + ai * 128 + m * 16);
                    const u32x4 y = *(const u32x4*)(YG + row * 2048 + col0 + bj * 128);
                    const f32x4 z0 = acc[ai][bj][m][0] + b0, z1 = acc[ai][bj][m][1] + b1;
                    u32x4 w;
                    w.x = cvt_pk_bf16(bf_lo(y.x) * sigmoidf_(z0[0]), bf_hi(y.x) * sigmoidf_(z0[1]));
                    w.y = cvt_pk_bf16(bf_lo(y.y) * sigmoidf_(z0[2]), bf_hi(y.y) * sigmoidf_(z0[3]));
                    w.z = cvt_pk_bf16(bf_lo(y.z) * sigmoidf_(z1[0]), bf_hi(y.z) * sigmoidf_(z1[1]));
                    w.w = cvt_pk_bf16(bf_lo(y.w) * sigmoidf_(z1[2]), bf_hi(y.w) * sigmoidf_(z1[3]));
                    *(u32x4*)(O + row * ldo + col0 + bj * 128) = w; } }
    }
};
struct EpiResX {
    static constexpr bool PERM = false, AFTER_DRAIN = false;
    bf16_t* CB; const bf16_t* baseB; int ld;
    __device__ __forceinline__ void operator()(const f32x4 (&acc)[2][2][4][2], const Unit& u, int wr, int wc, int fr, int fq) const {
        const int row0 = u.pm * 256 + wr * 64 + fr, col0 = u.pn * 256 + wc * 32 + 4 * fq;
#pragma unroll
        for (int ai = 0; ai < 2; ++ai)
#pragma unroll
            for (int m = 0; m < 4; ++m) { const size_t off = (size_t)(row0 + ai * 128 + m * 16) * ld + col0;
#pragma unroll
                for (int bj = 0; bj < 2; ++bj)
#pragma unroll
                    for (int n = 0; n < 2; ++n) { const u32x2 hb = *(const u32x2*)(baseB + off + bj * 128 + n * 16);
                        const f32x4 b = {bf_lo(hb.x), bf_hi(hb.x), bf_lo(hb.y), bf_hi(hb.y)};
                        const f32x4 r = b * ALPHA + acc[ai][bj][m][n];
                        u32x2 w; w.x = cvt_pk_bf16(r[0], r[1]); w.y = cvt_pk_bf16(r[2], r[3]); *(u32x2*)(CB + off + bj * 128 + n * 16) = w; } }
    }
};
struct EpiResB {
    static constexpr bool PERM = false, AFTER_DRAIN = false;
    bf16_t* CB; const bf16_t* baseB; int ld;
    __device__ __forceinline__ void operator()(const f32x4 (&acc)[2][2][4][2], const Unit& u, int wr, int wc, int fr, int fq) const {
        const int row0 = u.pm * 256 + wr * 64 + fr, col0 = u.pn * 256 + wc * 32 + 4 * fq;
#pragma unroll
        for (int ai = 0; ai < 2; ++ai)
#pragma unroll
            for (int m = 0; m < 4; ++m) { const size_t off = (size_t)(row0 + ai * 128 + m * 16) * ld + col0;
#pragma unroll
                for (int bj = 0; bj < 2; ++bj)
#pragma unroll
                    for (int n = 0; n < 2; ++n) { const u32x2 hb = *(const u32x2*)(baseB + off + bj * 128 + n * 16);
                        const f32x4 b = {bf_lo(hb.x), bf_hi(hb.x), bf_lo(hb.y), bf_hi(hb.y)};
                        const f32x4 r = b * ALPHA + acc[ai][bj][m][n];
                        u32x2 w; w.x = cvt_pk_bf16(r[0], r[1]); w.y = cvt_pk_bf16(r[2], r[3]); *(u32x2*)(CB + off + bj * 128 + n * 16) = w; } }
    }
};
struct EpiConvGate {
    static constexpr bool PERM = true, AFTER_DRAIN = false;
    bf16_t* ACT; bf16_t* GH; bf16_t* AH; const float* cw; const float* cb;
    __device__ __forceinline__ void operator()(f32x4 (&acc)[2][2][4][2], const Unit& u, int wr, int wc, int fr, int fq) const {
        const int ch0 = u.pn * 128 + wc * 32 + 8 * fq;
#pragma unroll
        for (int ai = 0; ai < 2; ++ai) {
            const int strip = 4 * u.pm + 2 * ai + wr;
            if (fr >= 14) { const f32x4 v0 = acc[ai][1][3][0], v1 = acc[ai][1][3][1];
                u32x4 w; w.x = cvt_pk_bf16(v0[0], v0[1]); w.y = cvt_pk_bf16(v0[2], v0[3]); w.z = cvt_pk_bf16(v1[0], v1[1]); w.w = cvt_pk_bf16(v1[2], v1[3]);
                *(u32x4*)(GH + (size_t)(strip * 4 + (fr - 14)) * DFF + ch0) = w; }
            if (fr < 2) { const f32x4 v0 = acc[ai][1][0][0], v1 = acc[ai][1][0][1], a0 = acc[ai][0][0][0], a1 = acc[ai][0][0][1];
                u32x4 w; w.x = cvt_pk_bf16(v0[0], v0[1]); w.y = cvt_pk_bf16(v0[2], v0[3]); w.z = cvt_pk_bf16(v1[0], v1[1]); w.w = cvt_pk_bf16(v1[2], v1[3]);
                *(u32x4*)(GH + (size_t)(strip * 4 + 2 + fr) * DFF + ch0) = w;
                w.x = cvt_pk_bf16(a0[0], a0[1]); w.y = cvt_pk_bf16(a0[2], a0[3]); w.z = cvt_pk_bf16(a1[0], a1[1]); w.w = cvt_pk_bf16(a1[2], a1[3]);
                *(u32x4*)(AH + (size_t)(strip * 2 + fr) * DFF + ch0) = w; }
        }
#define DPPF(x, ctrl) __builtin_bit_cast(float, __builtin_amdgcn_update_dpp(0, __builtin_bit_cast(int, (x)), (ctrl), 0xf, 0xf, true))
#pragma unroll
        for (int n = 0; n < 2; ++n) {
            const f32x4 w0v = *(const f32x4*)(cw + ch0 + 4 * n), w1v = *(const f32x4*)(cw + DFF + ch0 + 4 * n), w2v = *(const f32x4*)(cw + 2 * DFF + ch0 + 4 * n), bv = *(const f32x4*)(cb + ch0 + 4 * n);
#pragma unroll
            for (int e = 0; e < 4; ++e) {
                const float w0 = w0v[e], w1 = w1v[e], w2 = w2v[e], bb = bv[e];
#pragma unroll
                for (int ai = 0; ai < 2; ++ai) {
#pragma unroll
                    for (int m = 0; m < 4; ++m) {
                        const float g = acc[ai][1][m][n][e];
                        float g1 = DPPF(g, 0x111), g2 = DPPF(g, 0x112);
                        if (m > 0) { const float gp = acc[ai][1][m - 1][n][e]; g1 += DPPF(gp, 0x10F); g2 += DPPF(gp, 0x10E); }
                        const float gc = bb + w0 * g2 + w1 * g1 + w2 * g;
                        acc[ai][0][m][n][e] = gc * sigmoidf_(gc) * acc[ai][0][m][n][e];
                    }
                }
            }
        }
#undef DPPF
        const int row0 = u.pm * 256 + wr * 64 + fr;
#pragma unroll
        for (int ai = 0; ai < 2; ++ai)
#pragma unroll
            for (int m = 0; m < 4; ++m) { const f32x4 v0 = acc[ai][0][m][0], v1 = acc[ai][0][m][1];
                u32x4 w; w.x = cvt_pk_bf16(v0[0], v0[1]); w.y = cvt_pk_bf16(v0[2], v0[3]); w.z = cvt_pk_bf16(v1[0], v1[1]); w.w = cvt_pk_bf16(v1[2], v1[3]);
                *(u32x4*)(ACT + (size_t)(row0 + ai * 128 + m * 16) * DFF + ch0) = w; }
    }
};

template <bool OUTF> __device__ __forceinline__ void ln_rows(bf16_t* RB, float* OF, const float* gam, const float* bet) {
    const int lane = threadIdx.x & 63, gw = blockIdx.x * 8 + (threadIdx.x >> 6), nw = gridDim.x * 8;
    for (int row = gw; row < S; row += nw) {
        u32x4* r4 = (u32x4*)(RB + (size_t)row * D) + lane;
        f32x4 v[8][2]; float s = 0.f;
#pragma unroll
        for (int j = 0; j < 8; ++j) { const u32x4 w = r4[64 * j];
            v[j][0] = (f32x4){bf_lo(w.x), bf_hi(w.x), bf_lo(w.y), bf_hi(w.y)}; v[j][1] = (f32x4){bf_lo(w.z), bf_hi(w.z), bf_lo(w.w), bf_hi(w.w)};
            s += ((v[j][0][0] + v[j][0][1]) + (v[j][0][2] + v[j][0][3])) + ((v[j][1][0] + v[j][1][1]) + (v[j][1][2] + v[j][1][3])); }
        const float mean = wave_sum(s) * (1.0f / D); float q = 0.f;
#pragma unroll
        for (int j = 0; j < 8; ++j)
#pragma unroll
            for (int h = 0; h < 2; ++h) { v[j][h] = v[j][h] - mean; q += (v[j][h][0] * v[j][h][0] + v[j][h][1] * v[j][h][1]) + (v[j][h][2] * v[j][h][2] + v[j][h][3] * v[j][h][3]); }
        const float rstd = 1.0f / sqrtf(wave_sum(q) * (1.0f / D) + LN_EPS);
#pragma unroll
        for (int j = 0; j < 8; ++j) {
            const int e4 = 2 * (64 * j + lane);
            const f32x4 g0 = ((const f32x4*)gam)[e4], g1 = ((const f32x4*)gam)[e4 + 1], b0 = ((const f32x4*)bet)[e4], b1 = ((const f32x4*)bet)[e4 + 1];
            const f32x4 o0 = v[j][0] * rstd * g0 + b0, o1 = v[j][1] * rstd * g1 + b1;
            if (OUTF) { f32x4* op = (f32x4*)(OF + (size_t)row * D) + e4; __builtin_nontemporal_store(o0, op); __builtin_nontemporal_store(o1, op + 1); }
            else { u32x4 w; w.x = cvt_pk_bf16(o0[0], o0[1]); w.y = cvt_pk_bf16(o0[2], o0[3]); w.z = cvt_pk_bf16(o1[0], o1[1]); w.w = cvt_pk_bf16(o1[2], o1[3]); r4[64 * j] = w; }
        }
    }
}

template <int PASS> __device__ __forceinline__ void ssm_pass(const Params& p, LAS unsigned char* lds) {
    const int tid = threadIdx.x, lane = tid & 63, wid = tid >> 6, l15 = lane & 15, q4 = lane >> 4;
    const int gw = blockIdx.x * 8 + wid, nw = gridDim.x * 8;
    unsigned char* ws = p.ws;
    const bf16_t* P = (const bf16_t*)(ws + WS_P);
    const float* A = (const float*)(ws + WS_SSMA); const float* AL = (const float*)(ws + WS_SSMAL); const bf16_t* BB = (const bf16_t*)(ws + WS_SSMBB);
    float* E = (float*)(ws + WS_SSME); bf16_t* YG = (bf16_t*)(ws + WS_YG);
    LAS unsigned char* bu = lds + wid * (16 * 528);
    for (int item = gw; item < NG * NC; item += nw) {
        const int g = item / NC, c = item % NC;
        const float are = A[2 * (g * 64 + lane)], aim = A[2 * (g * 64 + lane) + 1];
        bf16x8 bbf[8];
#pragma unroll
        for (int blk = 0; blk < 8; ++blk) {
            bbf[blk] = (bf16x8){0, 0, 0, 0, 0, 0, 0, 0};
            if (q4 < 2) bbf[blk] = *(const bf16x8*)(BB + ((size_t)g * 128 + 16 * blk + l15) * 16 + 8 * q4);
        }
        bf16x8 cf[4]; f32x4 dsk = {0.f, 0.f, 0.f, 0.f};
        if (PASS == 2) {
#pragma unroll
            for (int ks = 0; ks < 4; ++ks) {
                const float* src = (ks < 2 ? p.in[7] : p.in[8]) + ((size_t)g * 16 + l15) * 64 + 32 * (ks & 1) + 8 * q4;
                const f32x4 a = *(const f32x4*)src, b = *(const f32x4*)(src + 4); const float sg = ks < 2 ? 1.0f : -1.0f;
                u32x4 w; w.x = cvt_pk_bf16(sg * a[0], sg * a[1]); w.y = cvt_pk_bf16(sg * a[2], sg * a[3]); w.z = cvt_pk_bf16(sg * b[0], sg * b[1]); w.w = cvt_pk_bf16(sg * b[2], sg * b[3]);
                cf[ks] = *(bf16x8*)&w;
            }
            dsk = *(const f32x4*)(p.in[9] + g * 16 + 4 * q4);
        }
        float hre = 0.f, him = 0.f;
        if (PASS == 2) {
            const float alr = AL[2 * (g * 64 + lane)], ali = AL[2 * (g * 64 + lane) + 1];
            for (int cc = 0; cc < c; ++cc) {
                const float er = E[((size_t)g * NC + cc) * 128 + lane], ei = E[((size_t)g * NC + cc) * 128 + 64 + lane];
                const float nr = alr * hre - ali * him + er, ni = alr * him + ali * hre + ei; hre = nr; him = ni;
            }
        }
        const int t0 = c * LC;
        for (int tile = 0; tile < LC / 16; ++tile) {
            const int tb = t0 + 16 * tile;
            bf16x8 uf = (bf16x8){0, 0, 0, 0, 0, 0, 0, 0};
            if (q4 < 2) uf = *(const bf16x8*)(P + (size_t)(tb + l15) * PW + g * 16 + 8 * q4);
#pragma unroll
            for (int blk = 0; blk < 8; ++blk) {
                f32x4 acc = {0.f, 0.f, 0.f, 0.f};
                acc = __builtin_amdgcn_mfma_f32_16x16x32_bf16(bbf[blk], uf, acc, 0, 0, 0);
                *(LAS f32x4*)(bu + l15 * 528 + (16 * blk + 4 * q4) * 4) = acc;
            }
            LDS_WAIT();
#pragma unroll
            for (int t = 0; t < 16; ++t) {
                const float br = *(const LAS float*)(bu + t * 528 + lane * 4), bi = *(const LAS float*)(bu + t * 528 + 256 + lane * 4);
                const float nr = are * hre - aim * him + br, ni = are * him + aim * hre + bi; hre = nr; him = ni;
                if (PASS == 2) {
                    const unsigned w = cvt_pk_bf16(hre, him);
                    *(LAS unsigned short*)(bu + t * 528 + lane * 2) = (unsigned short)(w & 0xffffu);
                    *(LAS unsigned short*)(bu + t * 528 + 128 + lane * 2) = (unsigned short)(w >> 16);
                }
            }
            if (PASS == 2) {
                LDS_WAIT();
                f32x4 y = {0.f, 0.f, 0.f, 0.f};
#pragma unroll
                for (int ks = 0; ks < 4; ++ks) {
                    const bf16x8 hb = *(const LAS bf16x8*)(bu + l15 * 528 + ks * 64 + q4 * 16);
                    y = __builtin_amdgcn_mfma_f32_16x16x32_bf16(cf[ks], hb, y, 0, 0, 0);
                }
                const u32x2 uu = *(const u32x2*)(P + (size_t)(tb + l15) * PW + g * 16 + 4 * q4);
                const float y0 = gelu_tanh(y[0] + dsk[0] * bf_lo(uu.x)), y1 = gelu_tanh(y[1] + dsk[1] * bf_hi(uu.x));
                const float y2 = gelu_tanh(y[2] + dsk[2] * bf_lo(uu.y)), y3 = gelu_tanh(y[3] + dsk[3] * bf_hi(uu.y));
                u32x2 w; w.x = cvt_pk_bf16(y0, y1); w.y = cvt_pk_bf16(y2, y3);
                *(u32x2*)(YG + (size_t)(tb + l15) * 2048 + g * 16 + 4 * q4) = w;
                LDS_WAIT();
            }
        }
        if (PASS == 1) { E[((size_t)g * NC + c) * 128 + lane] = hre; E[((size_t)g * NC + c) * 128 + 64 + lane] = him; }
    }
}

constexpr int AT_KB = 64 * 512, AT_VB = 256 * 128, AT_STAGE = AT_KB + AT_VB, AT_TBL = 2 * AT_STAGE, AT_XROW = 1040;
__device__ __forceinline__ int t5_bucket(int rel) {
    const int n = rel < 0 ? -rel : rel; int b;
    if (n < 8) b = n; else if (n < 12) b = 8; else if (n < 16) b = 9; else if (n < 23) b = 10; else if (n < 32) b = 11; else if (n < 46) b = 12; else if (n < 64) b = 13; else if (n < 91) b = 14; else b = 15;
    return b + (rel > 0 ? 16 : 0);
}
__device__ __forceinline__ void attn_item(const Params& p, LAS unsigned char* lds, int head, int j) {
    int tid_ = threadIdx.x; asm volatile("" : "+v"(tid_));
    const int tid = tid_, lane = tid & 63, wid = __builtin_amdgcn_readfirstlane(tid >> 6), l31 = lane & 31, half = lane >> 5;
    const int rg = wid >> 1, c = wid & 1;
    unsigned char* ws = p.ws;
    const bf16_t* P = (const bf16_t*)(ws + WS_P); const bf16_t* VT = (const bf16_t*)(ws + WS_VT); bf16_t* MIXA = (bf16_t*)(ws + WS_MIXA);
    const float lam = ((const float*)(ws + WS_CTL))[0];
    const int q0 = 128 * j, nkt = 2 * j + 2;
    LAS float* tbl = (LAS float*)(lds + AT_TBL);
    if (tid < 320) tbl[tid] = p.in[17][t5_bucket(tid - 256) * 8 + head] * LOG2E;
    const float bfar = p.in[17][15 * 8 + head] * LOG2E;
    const float CS = 0.08838834764831845f * LOG2E;
    const unsigned qoff0 = (unsigned)(((32 * rg + l31) * PW + c * 128 + 8 * half) * 2);
    const char* qbase = (const char*)(P + (size_t)q0 * PW + 2048 + head * 256);
    bf16x8 qf[8];
#pragma unroll
    for (int ks = 0; ks < 8; ++ks) qf[ks] = *(const bf16x8*)(qbase + qoff0 + 32 * ks);
    const char* kgb = (const char*)(P + 4096 + head * 256); const char* vgb = (const char*)(VT + (size_t)head * 256 * S);
#define AT_DMA(kt, buf) do { int ln = lane; asm volatile("" : "+v"(ln)); _Pragma("unroll") for (int i = 0; i < 4; ++i) { \
        const int n_ = 4 * wid + i, kr_ = 2 * n_ + (ln >> 5), kc_ = (ln & 31) ^ (kr_ & 15), vr_ = 8 * n_ + (ln >> 3), vc_ = (ln & 7) ^ ((vr_ >> 1) & 7); \
        const unsigned ko_ = (unsigned)(kr_ * PW + kc_ * 8) * 2u, vo_ = (unsigned)(vr_ * S + vc_ * 8) * 2u; \
        __builtin_amdgcn_global_load_lds((const unsigned*)(kgb + (size_t)(kt) * 64 * PW * 2 + ko_), (LAS unsigned*)(lds + (buf) * AT_STAGE + (4 * wid + i) * 1024), 16, 0, 0); \
        __builtin_amdgcn_global_load_lds((const unsigned*)(vgb + (size_t)(kt) * 128 + vo_), (LAS unsigned*)(lds + (buf) * AT_STAGE + AT_KB + (4 * wid + i) * 1024), 16, 0, 0); } } while (0)
#define AT_VMWAIT() asm volatile("s_waitcnt vmcnt(0)" ::: "memory")
    const int kbase0 = l31 * 512 + c * 256 + (((l31 & 14) | (half ^ (l31 & 1))) << 4);
    const int vbase0 = l31 * 128 + ((half ^ (l31 >> 4)) & 1) * 8 + (((l31 >> 1) & 7) << 4);
    const int xoff0 = (32 * rg + l31) * AT_XROW;
    f32x16 o[8];
#pragma unroll
    for (int db = 0; db < 8; ++db)
#pragma unroll
        for (int r = 0; r < 16; ++r) o[db][r] = 0.f;
    float m_ref = -__builtin_inff(), lsum = 0.f;
#define AT_BAR() do { asm volatile("" ::: "memory"); __builtin_amdgcn_s_barrier(); asm volatile("" ::: "memory"); } while (0)
#define AT_QK(hb) do { bf16x8 kf[8]; \
        _Pragma("unroll") for (int ks = 0; ks < 8; ++ks) kf[ks] = *(const LAS bf16x8*)(Kb + (kbase ^ (ks * 32)) + (hb) * 32 * 512); \
        _Pragma("unroll") for (int r = 0; r < 16; ++r) s[r] = 0.f; \
        _Pragma("unroll") for (int ks = 0; ks < 8; ++ks) s = __builtin_amdgcn_mfma_f32_32x32x16_bf16(kf[ks], qf[ks], s, 0, 0, 0); } while (0)
#define AT_SM(hb) do { \
        const bool near_ = kt >= nkt - 4; float mx; \
        if (near_) { const LAS float* tb = tbl + (kt * 64 + 32 * (hb) + 4 * half - (q0 + 32 * rg + l31) + 256); \
            _Pragma("unroll") for (int r = 0; r < 16; ++r) s[r] = s[r] * CS + tb[(r & 3) + 8 * (r >> 2)]; \
            mx = s[0]; \
            _Pragma("unroll") for (int r = 1; r < 16; ++r) mx = fmaxf(mx, s[r]); \
        } else { mx = s[0]; \
            _Pragma("unroll") for (int r = 1; r < 16; ++r) mx = fmaxf(mx, s[r]); \
            mx = mx * CS + bfar; }                                            \
        mx = fmaxf(mx, __shfl_xor(mx, 32)); \
        if (__any(mx > m_ref + 8.0f)) { \
            const float mn = fmaxf(m_ref, mx); const float al = __builtin_amdgcn_exp2f(m_ref - mn); m_ref = mn; lsum *= al; \
            _Pragma("unroll") for (int db = 0; db < 8; ++db) _Pragma("unroll") for (int r = 0; r < 16; ++r) o[db][r] *= al; } \
        float ps = 0.f; \
        if (near_) { _Pragma("unroll") for (int r = 0; r < 16; ++r) { s[r] = __builtin_amdgcn_exp2f(s[r] - m_ref); ps += s[r]; } } \
        else { const float bm_ = bfar - m_ref; _Pragma("unroll") for (int r = 0; r < 16; ++r) { s[r] = __builtin_amdgcn_exp2f(s[r] * CS + bm_); ps += s[r]; } } \
        lsum += ps; \
        { u32x4 w; \
          w.x = cvt_pk_bf16(s[0], s[1]); w.y = cvt_pk_bf16(s[2], s[3]); w.z = cvt_pk_bf16(s[4], s[5]); w.w = cvt_pk_bf16(s[6], s[7]); pf[0] = *(bf16x8*)&w; \
          w.x = cvt_pk_bf16(s[8], s[9]); w.y = cvt_pk_bf16(s[10], s[11]); w.z = cvt_pk_bf16(s[12], s[13]); w.w = cvt_pk_bf16(s[14], s[15]); pf[1] = *(bf16x8*)&w; } } while (0)
#define AT_VLOAD(hb, db_) do { int vb_ = vbase0 + (db_) * 4096; asm volatile("" : "+v"(vb_)); _Pragma("unroll") for (int s2 = 0; s2 < 2; ++s2) { \
        const u32x2 lo_ = *(const LAS u32x2*)(Vb + (vb_ ^ ((2 * (hb) + s2) * 32))), hi_ = *(const LAS u32x2*)(Vb + (vb_ ^ ((2 * (hb) + s2) * 32 + 16))); \
        vf[(db_) & 1][s2] = (u32x4){lo_.x, lo_.y, hi_.x, hi_.y}; } } while (0)
#define AT_PV(hb) do { u32x4 vf[2][2]; AT_VLOAD(hb, 0); \
        _Pragma("unroll") for (int db = 0; db < 8; ++db) { \
            if (db + 1 < 8) AT_VLOAD(hb, db + 1); \
            o[db] = __builtin_amdgcn_mfma_f32_32x32x16_bf16(*(bf16x8*)&vf[db & 1][0], pf[0], o[db], 0, 0, 0); \
            o[db] = __builtin_amdgcn_mfma_f32_32x32x16_bf16(*(bf16x8*)&vf[db & 1][1], pf[1], o[db], 0, 0, 0); } } while (0)
    AT_DMA(0, 0); AT_VMWAIT();
    __syncthreads();
    if (wid >= 4) AT_BAR();
    f32x16 s; bf16x8 pf[2];
#pragma unroll
    for (int r = 0; r < 16; ++r) s[r] = 0.f;
    pf[0] = (bf16x8){0, 0, 0, 0, 0, 0, 0, 0}; pf[1] = pf[0];
    for (int kt = 0; kt < nkt; ++kt) {
        const int cur = kt & 1;
        const bool more = kt + 1 < nkt;
        const bool active = !(kt == 2 * j + 1 && rg < 2);
        const LAS unsigned char* Kb = lds + cur * AT_STAGE; const LAS unsigned char* Vb = Kb + AT_KB;
        int kbase = kbase0; asm volatile("" : "+v"(kbase));
        if (active) { AT_QK(0); AT_SM(0); }
        AT_BAR();
        if (more) AT_DMA(kt + 1, cur ^ 1);
        if (active) { AT_PV(0); AT_QK(1); }
        AT_BAR();
        if (active) { AT_SM(1); }
        AT_VMWAIT();
        AT_BAR();
        if (active) { AT_PV(1); }
        AT_BAR();
    }
    if (wid < 4) AT_BAR();
#undef AT_BAR
#undef AT_QK
#undef AT_SM
#undef AT_VLOAD
#undef AT_PV
#undef AT_DMA
    const float ltot = lsum + __shfl_xor(lsum, 32);
    const float inv = 1.0f / ltot;
    int xo = xoff0 + 16 * half; asm volatile("" : "+v"(xo));
    if (c == 1) {
        LAS unsigned char* xrow = lds + xo;
        const float f = lam * inv;
#pragma unroll
        for (int db = 0; db < 8; ++db)
#pragma unroll
            for (int r4 = 0; r4 < 4; ++r4) {
                f32x4 v = {o[db][4 * r4] * f, o[db][4 * r4 + 1] * f, o[db][4 * r4 + 2] * f, o[db][4 * r4 + 3] * f};
                *(LAS f32x4*)(xrow + (32 * db + 8 * r4) * 4) = v;
            }
    }
    __syncthreads();
    if (c == 0) {
        asm volatile("" : "+v"(xo));
        LAS unsigned char* xrow = lds + xo;
        float ss = 0.f;
#pragma unroll
        for (int db = 0; db < 8; ++db)
#pragma unroll
            for (int r4 = 0; r4 < 4; ++r4) {
                const f32x4 x1 = *(const LAS f32x4*)(xrow + (32 * db + 8 * r4) * 4);
#pragma unroll
                for (int e = 0; e < 4; ++e) { const float x = o[db][4 * r4 + e] * inv - x1[e]; o[db][4 * r4 + e] = x; ss += x * x; }
                if ((r4 & 1) == 1) __builtin_amdgcn_sched_barrier(0);
            }
        ss += __shfl_xor(ss, 32);
        const float rms = (1.0f - LAMBDA_INIT) / sqrtf(ss * (1.0f / 256.0f) + LN_EPS);
        LDS_WAIT();
        int xb = xoff0 + 8 * half; asm volatile("" : "+v"(xb));
        LAS unsigned char* brow = lds + xb;
        int go = 16 * half; asm volatile("" : "+v"(go));
        const char* gp = (const char*)p.in[16] + go;
#pragma unroll
        for (int db = 0; db < 8; ++db)
#pragma unroll
            for (int r4 = 0; r4 < 4; ++r4) {
                const f32x4 g = *(const f32x4*)(gp + (32 * db + 8 * r4) * 4);
                u32x2 w; w.x = cvt_pk_bf16(o[db][4 * r4] * rms * g[0], o[db][4 * r4 + 1] * rms * g[1]); w.y = cvt_pk_bf16(o[db][4 * r4 + 2] * rms * g[2], o[db][4 * r4 + 3] * rms * g[3]);
                *(LAS u32x2*)(brow + (32 * db + 8 * r4) * 2) = w;
                if ((r4 & 1) == 1) __builtin_amdgcn_sched_barrier(0);
            }
    }
    __syncthreads();
    {
        int co = (tid >> 5) * AT_XROW + (tid & 31) * 16; asm volatile("" : "+v"(co));
        unsigned mo = (unsigned)(((tid >> 5) * D + (tid & 31) * 8) * 2); asm volatile("" : "+v"(mo));
        char* mb = (char*)(MIXA + (size_t)q0 * D + 2048 + head * 256);
#pragma unroll
        for (int i = 0; i < 8; ++i) {
            const u32x4 w = *(const LAS u32x4*)(lds + co + i * 16 * AT_XROW);
            *(u32x4*)(mb + mo + (size_t)i * 16 * D * 2) = w;
        }
    }
    __syncthreads();
}
__device__ __forceinline__ void attn_phase(const Params& p, LAS unsigned char* lds) {
    for (int pr = blockIdx.x; pr < 256; pr += gridDim.x) {
        const int head = pr & 7, i = pr >> 3;
        attn_item(p, lds, head, 63 - i);
        attn_item(p, lds, head, i);
    }
}

__device__ __forceinline__ void unpack8(const u32x4 v, float (&f)[8]) { f[0] = bf_lo(v.x); f[1] = bf_hi(v.x); f[2] = bf_lo(v.y); f[3] = bf_hi(v.y); f[4] = bf_lo(v.z); f[5] = bf_hi(v.z); f[6] = bf_lo(v.w); f[7] = bf_hi(v.w); }
__device__ __forceinline__ void conv_fix(const Params& p) {
    const bf16_t* GH = (const bf16_t*)(p.ws + WS_GH); const bf16_t* AH = (const bf16_t*)(p.ws + WS_AH); bf16_t* ACT = (bf16_t*)(p.ws + WS_ACT);
    const float* cw = p.in[22]; const float* cb = p.in[23];
    const int gt = blockIdx.x * 512 + threadIdx.x, ngt = gridDim.x * 512;
    constexpr int NV = DFF / 8, NSTRIP = S / 64;
    for (int it = gt; it < NV * NSTRIP; it += ngt) {
        const int cv = it % NV, st = it / NV, ch = cv * 8;
        float gm2[8], gm1[8], g0[8], g1[8], a0[8], a1[8];
#pragma unroll
        for (int e = 0; e < 8; ++e) { gm2[e] = 0.f; gm1[e] = 0.f; }
        if (st > 0) { unpack8(*(const u32x4*)(GH + (size_t)((st - 1) * 4 + 0) * DFF + ch), gm2); unpack8(*(const u32x4*)(GH + (size_t)((st - 1) * 4 + 1) * DFF + ch), gm1); }
        unpack8(*(const u32x4*)(GH + (size_t)(st * 4 + 2) * DFF + ch), g0); unpack8(*(const u32x4*)(GH + (size_t)(st * 4 + 3) * DFF + ch), g1);
        unpack8(*(const u32x4*)(AH + (size_t)(st * 2 + 0) * DFF + ch), a0); unpack8(*(const u32x4*)(AH + (size_t)(st * 2 + 1) * DFF + ch), a1);
        float r0[8], r1[8];
#pragma unroll
        for (int e = 0; e < 8; ++e) {
            const float w0 = cw[ch + e], w1 = cw[DFF + ch + e], w2 = cw[2 * DFF + ch + e], bb = cb[ch + e];
            const float c0 = bb + w0 * gm2[e] + w1 * gm1[e] + w2 * g0[e], c1 = bb + w0 * gm1[e] + w1 * g0[e] + w2 * g1[e];
            r0[e] = c0 * sigmoidf_(c0) * a0[e]; r1[e] = c1 * sigmoidf_(c1) * a1[e];
        }
        u32x4 w; w.x = cvt_pk_bf16(r0[0], r0[1]); w.y = cvt_pk_bf16(r0[2], r0[3]); w.z = cvt_pk_bf16(r0[4], r0[5]); w.w = cvt_pk_bf16(r0[6], r0[7]);
        *(u32x4*)(ACT + (size_t)(st * 64) * DFF + ch) = w;
        w.x = cvt_pk_bf16(r1[0], r1[1]); w.y = cvt_pk_bf16(r1[2], r1[3]); w.z = cvt_pk_bf16(r1[4], r1[5]); w.w = cvt_pk_bf16(r1[6], r1[7]);
        *(u32x4*)(ACT + (size_t)(st * 64 + 1) * DFF + ch) = w;
    }
}

#define XB_TMO      128
#define XB_XCNT(j)  (256  + 64 * (j))
#define XB_XSUB(j)  (1280 + 64 * (j))
#define XB_XGEN(j)  (2304 + 64 * (j))
#define XB_TOP      3328
#define XB_TOPGEN   3392
#define XCD_BAR_WORDS 3456
#define XB_SPIN_CAP (1u << 18)

__device__ __forceinline__ unsigned xb_ld(unsigned* p)              { return __hip_atomic_load(p, __ATOMIC_RELAXED, __HIP_MEMORY_SCOPE_AGENT); }
__device__ __forceinline__ unsigned xb_add(unsigned* p, unsigned v) { return __hip_atomic_fetch_add(p, v, __ATOMIC_RELAXED, __HIP_MEMORY_SCOPE_AGENT); }
__device__ __forceinline__ unsigned xb_xcc_id() { return (unsigned)__builtin_amdgcn_s_getreg((3 << 11) | 20) & 0xFu; }
#define XB_SPIN(cond, bar) do { unsigned _sp = 0; while (cond) { __builtin_amdgcn_s_sleep(1); \
    if ((++_sp & 255u) == 0u) { if (xb_ld(&(bar)[XB_TMO])) break; if (_sp > XB_SPIN_CAP) { atomicAdd(&(bar)[XB_TMO], 1u); break; } } } } while (0)

struct XcdBarrier {
    unsigned* bar; unsigned x;
    volatile LAS unsigned* st;
};

__device__ __forceinline__ XcdBarrier xcd_barrier_post(unsigned* bar, volatile LAS unsigned* st) {
    XcdBarrier b; b.bar = bar; b.x = xb_xcc_id(); b.st = st;
    if (threadIdx.x == 0) (void)xb_add(&bar[XB_XCNT(b.x)], 1u);
    return b;
}
__device__ __forceinline__ void xcd_barrier_complete(unsigned* bar, unsigned x, unsigned& nloc, unsigned& nx) {
    const unsigned G = gridDim.x * gridDim.y * gridDim.z;
    unsigned sum, cnt, mine, sp = 0u;
    for (;;) {
        sum = 0u; cnt = 0u; mine = 0u;
#pragma unroll
        for (unsigned j = 0; j < 16; ++j) { const unsigned c = xb_ld(&bar[XB_XCNT(j)]); sum += c; cnt += (c > 0u) ? 1u : 0u; mine = (j == x) ? c : mine; }
        if (sum == G) break;
        __builtin_amdgcn_s_sleep(1);
        if ((++sp & 255u) == 0u) { if (xb_ld(&bar[XB_TMO])) break; if (sp > XB_SPIN_CAP) { atomicAdd(&bar[XB_TMO], 1u); break; } }
    }
    nloc = mine > 0u ? mine : 1u; nx = cnt > 0u ? cnt : 1u;
}

__device__ __forceinline__ void xcd_barrier(const XcdBarrier& b) {
    asm volatile("s_waitcnt vmcnt(0)" ::: "memory");
    __syncthreads();
    if (threadIdx.x == 0) {
        unsigned* bar = b.bar;
        __builtin_amdgcn_s_waitcnt(0);
        unsigned nloc = b.st[0], nx = b.st[1];
        if (nloc == 0u) { xcd_barrier_complete(bar, b.x, nloc, nx); b.st[0] = nloc; b.st[1] = nx; }
        const unsigned old = xb_add(&bar[XB_XSUB(b.x)], 1u);
        const unsigned gen = old / nloc;
        if (old + 1u == (gen + 1u) * nloc) {
            __builtin_amdgcn_fence(__ATOMIC_RELEASE, "agent");
            asm volatile("s_waitcnt vmcnt(0)" ::: "memory");
            const unsigned og = xb_add(&bar[XB_TOP], 1u);
            const unsigned tg = og / nx;
            if (og + 1u == (tg + 1u) * nx) xb_add(&bar[XB_TOPGEN], 1u);
            else XB_SPIN(xb_ld(&bar[XB_TOPGEN]) == tg, bar);
            __builtin_amdgcn_fence(__ATOMIC_ACQUIRE, "agent");
            xb_add(&bar[XB_XGEN(b.x)], 1u);
            asm volatile("s_waitcnt vmcnt(0)" ::: "memory");
        } else {
            XB_SPIN(xb_ld(&bar[XB_XGEN(b.x)]) == gen, bar);
            __builtin_amdgcn_fence(__ATOMIC_ACQUIRE, "agent");
            asm volatile("s_waitcnt vmcnt(0)" ::: "memory");
        }
    }
    __syncthreads();
}

#ifndef GEMM_SP2
#define GEMM_SP2 true
#endif
#ifndef GEMM_ALIGN_EPI
#define GEMM_ALIGN_EPI true
#endif
template <class Epi> __device__ __forceinline__ void run_gemm(LAS unsigned char* lds, const bf16_t* A, const bf16_t* Bt, int M, int N, int K, const Epi& E) {
    pg8::Gemm g{A, Bt, M, N, K}; pg8::StaticOrder So; So.init(M, N, (int)gridDim.x, (int)blockIdx.x);
    pg8::gemm_phase<Epi, pg8::StaticOrder, GEMM_ALIGN_EPI, GEMM_SP2>(lds, g, So, E);
}

__global__ void __launch_bounds__(512, 2) mega(Params p) {
    extern __shared__ __attribute__((aligned(16))) unsigned char shm[];
    LAS unsigned char* lds = (LAS unsigned char*)shm;
    cg::grid_group grid = cg::this_grid();
    unsigned char* ws = p.ws;
#ifndef PHMASK
#define PHMASK 0x7ff
#endif
#define IN(k) ((((PHMASK) >> (k)) & 1) && p.ph_lo <= (k) && (k) < p.ph_hi)
#define SEAM(k) do { if (IN(k) && IN((k) + 1)) xcd_barrier(xbar); } while (0)
    if (threadIdx.x < 4) ((volatile LAS unsigned*)(lds + LDS_XB))[threadIdx.x] = 0u;
    __syncthreads();
    if (IN(0)) phase0(p, lds);
    if (IN(0) && IN(1)) grid.sync();
    XcdBarrier xbar = xcd_barrier_post((unsigned*)(ws + WS_CTL + CTL_BAR), (volatile LAS unsigned*)(lds + LDS_XB));
    if (IN(1)) {
        run_gemm(lds, (const bf16_t*)(ws + WS_XB), (const bf16_t*)(ws + WS_WIN), S, PW, D, EpiBf16Plain{(bf16_t*)(ws + WS_P), PW});
        run_gemm(lds, (const bf16_t*)(ws + WS_WIN) + (size_t)PW * D, (const bf16_t*)(ws + WS_XB), 2048, S, D, EpiBf16PlainT<true>{(bf16_t*)(ws + WS_VT), S});
    }
    SEAM(1);
    if (IN(2)) ssm_pass<1>(p, lds);
    SEAM(2);
    if (IN(3)) {
#ifndef NO_ATT
        attn_phase(p, lds);
#endif
#ifndef NO_SSM2
        ssm_pass<2>(p, lds);
#endif
        __syncthreads(); }
    SEAM(3);
    if (IN(4)) run_gemm(lds, (const bf16_t*)(ws + WS_YG), (const bf16_t*)(ws + WS_WGLU), S, 2048, 2048, EpiGlu{(bf16_t*)(ws + WS_MIXA), D, (const bf16_t*)(ws + WS_YG), p.in[11]});
    SEAM(4);
    if (IN(5)) run_gemm(lds, (const bf16_t*)(ws + WS_MIXA), (const bf16_t*)(ws + WS_WOUT), S, D, D, EpiResX{(bf16_t*)(ws + WS_H1B), (const bf16_t*)(ws + WS_XB), D});
    SEAM(5);
    if (IN(6)) ln_rows<false>((bf16_t*)(ws + WS_H1B), nullptr, p.in[19], p.in[20]);
    SEAM(6);
    if (IN(7)) run_gemm(lds, (const bf16_t*)(ws + WS_H1B), (const bf16_t*)(ws + WS_WUP), S, UPW, D, EpiConvGate{(bf16_t*)(ws + WS_ACT), (bf16_t*)(ws + WS_GH), (bf16_t*)(ws + WS_AH), p.in[22], p.in[23]});
    SEAM(7);
    if (IN(8)) conv_fix(p);
    SEAM(8);
    if (IN(9)) run_gemm(lds, (const bf16_t*)(ws + WS_ACT), (const bf16_t*)(ws + WS_WDOWN), S, D, DFF, EpiResB{(bf16_t*)(ws + WS_R1), (const bf16_t*)(ws + WS_H1B), D});
    SEAM(9);
    if (IN(10)) ln_rows<true>((bf16_t*)(ws + WS_R1), p.out, p.in[25], p.in[26]);
#undef IN
#undef SEAM
}
}

extern "C" void kernel_launch(void* const* d_in, const int* in_sizes, int n_in, void* d_out, int out_size, void* d_ws, size_t ws_size, hipStream_t stream) {
    static int grid = 0;
    if (grid == 0) {
        if (n_in != 27 || ws_size < mk::WS_END) { fprintf(stderr, "kernel_launch: unexpected inputs (n_in %d, ws %zu)\n", n_in, ws_size); grid = -1; return; }
        int dev = 0, cus = 0, per_cu = 0;
        (void)hipGetDevice(&dev); (void)hipDeviceGetAttribute(&cus, hipDeviceAttributeMultiprocessorCount, dev);
        if (hipFuncSetAttribute((const void*)mk::mega, hipFuncAttributeMaxDynamicSharedMemorySize, mk::LDS_BYTES) != hipSuccess) { fprintf(stderr, "kernel_launch: hipFuncSetAttribute failed\n"); grid = -1; return; }
        if (hipOccupancyMaxActiveBlocksPerMultiprocessor(&per_cu, (const void*)mk::mega, 512, mk::LDS_BYTES) != hipSuccess || per_cu < 1) { fprintf(stderr, "kernel_launch: occupancy query says %d\n", per_cu); per_cu = 1; }
        (void)hipGetLastError();
        grid = cus * 1;
        if (grid <= 0) grid = 256;
    }
    if (grid < 0) return;
    mk::Params p{};
    for (int i = 0; i < 27; ++i) p.in[i] = (const float*)d_in[i];
    p.out = (float*)d_out; p.ws = (unsigned char*)d_ws; p.ph_lo = 0; p.ph_hi = 11;
    void* args[] = {&p};
    const hipError_t e = hipLaunchCooperativeKernel((const void*)mk::mega, dim3(grid), dim3(512), args, mk::LDS_BYTES, stream);
    if (e != hipSuccess) fprintf(stderr, "kernel_launch: cooperative launch failed: %s (grid %d)\n", hipGetErrorString(e), grid);
}
```

```cpp
#include <hip/hip_runtime.h>
#include <hip/hip_cooperative_groups.h>
#include <cstdio>
namespace cg = cooperative_groups;
#include <hip/hip_runtime.h>
namespace pg8 {
#define PG8_LAS __attribute__((address_space(3)))
typedef unsigned short bf16_t;
typedef short bf16x8 __attribute__((ext_vector_type(8)));
typedef float f32x4 __attribute__((ext_vector_type(4)));
typedef unsigned u32x4 __attribute__((ext_vector_type(4)));
constexpr int BM = 256, BK = 64, HALF = 128, HTB = HALF * BK * 2  , STAGE_BYTES = 8 * HTB, NXCD = 8, WGM = 8;

__host__ __device__ __forceinline__ int lds_byte(int r, int c) { const int st = (r >> 4) * 2 + (c >> 5), rr = r & 15, cc = c & 31, ob = rr * 64 + cc * 2; return st * 1024 + (ob ^ (((ob >> 9) & 1) << 5)); }
__host__ __device__ __forceinline__ void stage_rc(int b, int& R, int& C) { const int st = b / 1024, sb = b % 1024, swz = sb ^ (((sb >> 9) & 1) << 5); R = (st >> 1) * 16 + swz / 64; C = (st & 1) * 32 + (swz % 64) / 2; }
__host__ __device__ __forceinline__ int perm32(int rho) { const int n = rho >> 4, i = rho & 15; return 8 * (i >> 2) + 4 * n + (i & 3); }

struct Unit { int pm, pn; };
struct Gemm { const bf16_t* A; const bf16_t* Bt; int M, N, K; };

struct StaticOrder {
    int nM, nN, nwg, G, c;
    __host__ __device__ void init(int M, int N, int G_, int c_) { nM = M / BM; nN = N / BM; nwg = nM * nN; G = G_; c = c_; }
    __host__ __device__ bool next(int i, Unit& u) const {
        const long L = (long)i * G + c; if (L >= nwg) return false;
        int wgid = (int)L; { const int q = nwg / NXCD, r = nwg % NXCD, xcd = wgid % NXCD, off = wgid / NXCD; wgid = (xcd < r ? xcd * (q + 1) : r * (q + 1) + (xcd - r) * q) + off; }
        const int nig = WGM * nN, gid = wgid / nig, fm = gid * WGM, gsz = (nM - fm) < WGM ? (nM - fm) : WGM;
        u.pm = fm + ((wgid % nig) % gsz); u.pn = (wgid % nig) / gsz; return true;
    }
    __device__ __forceinline__ void a_ready(const Unit&) const {}
    __device__ __forceinline__ void done(const Unit&) const {}
};
__device__ __forceinline__ unsigned cvt_pk_bf16(float lo, float hi) { unsigned r; asm volatile("v_cvt_pk_bf16_f32 %0, %1, %2" : "=v"(r) : "v"(lo), "v"(hi)); return r; }
template <class Epi, class Sched, bool ALIGN_EPI = false, bool SP2 = false>
__device__ __forceinline__ void gemm_phase(PG8_LAS unsigned char* lds, const Gemm g, const Sched& S, const Epi& E) {
    const int tid = threadIdx.x, wid = __builtin_amdgcn_readfirstlane(tid >> 6), lane = tid & 63, wr = wid >> 2, wc = wid & 3, fr = lane & 15, fq = lane >> 4;
    const int K = g.K, nt = K / BK;
    unsigned voffA[2], voffB[2];
#pragma unroll
    for (int i = 0; i < 2; ++i) { int R, C; stage_rc(tid * 16 + i * 8192, R, C); const int Rb = Epi::PERM ? ((R & ~31) + perm32(R & 31)) : R;
        voffA[i] = (unsigned)(R * K + C) * 2u; voffB[i] = (unsigned)(Rb * K + C) * 2u; }
    const size_t kstep = (size_t)(BK * 2);
    const size_t hstep = (size_t)HALF * K * 2;
    const size_t tstep = 2 * hstep;
    const unsigned ldsw = (unsigned)wid * 1024u;
    const int aoff = lds_byte(wr * 64 + fr, fq * 8), boff = lds_byte(wc * 32 + fr, fq * 8);
#define PG8_SA(b, h) (((b) * 2 + (h)) * HTB)
#define PG8_SB(b, h) ((4 + (b) * 2 + (h)) * HTB)
#define PG8_STAGE(bufoff, gbase, voff) do { _Pragma("unroll") for (int _i = 0; _i < 2; ++_i) \
        __builtin_amdgcn_global_load_lds((const unsigned*)((const char*)(gbase) + (voff)[_i]), (PG8_LAS unsigned*)(lds + (bufoff) + ldsw + _i * 8192), 16, 0, 0); } while (0)
#define PG8_LDA(dst, b, h) do { _Pragma("unroll") for (int m = 0; m < 4; ++m) _Pragma("unroll") for (int k = 0; k < 2; ++k) dst[m][k] = *(const PG8_LAS bf16x8*)(lds + PG8_SA(b, h) + aoff + m * 2048 + k * 1024); } while (0)
#define PG8_LDB(dst, b, h) do { _Pragma("unroll") for (int n = 0; n < 2; ++n) _Pragma("unroll") for (int k = 0; k < 2; ++k) dst[n][k] = *(const PG8_LAS bf16x8*)(lds + PG8_SB(b, h) + boff + n * 2048 + k * 1024); } while (0)
#define PG8_MMA(ai, bj, At, Bt) do { __builtin_amdgcn_s_setprio(1); _Pragma("unroll") for (int m = 0; m < 4; ++m) _Pragma("unroll") for (int n = 0; n < 2; ++n) _Pragma("unroll") for (int k = 0; k < 2; ++k) \
        acc[ai][bj][m][n] = __builtin_amdgcn_mfma_f32_16x16x32_bf16(Bt[n][k], At[m][k], acc[ai][bj][m][n], 0, 0, 0); __builtin_amdgcn_s_setprio(0); } while (0)
#define PG8_WAIT_V(n) asm volatile("s_waitcnt vmcnt(" #n ")" ::: "memory")
#define PG8_WAIT_L(n) asm volatile("s_waitcnt lgkmcnt(" #n ")" ::: "memory")
#define PG8_BAR __builtin_amdgcn_s_barrier()
#define PG8_SCHED __builtin_amdgcn_sched_barrier(0)
    Unit cur, nxt; int ui = 0;
    if (!S.next(0, cur)) return;
    f32x4 acc[2][2][4][2];
#pragma unroll
    for (int a = 0; a < 2; ++a)
#pragma unroll
        for (int b = 0; b < 2; ++b)
#pragma unroll
            for (int m = 0; m < 4; ++m)
#pragma unroll
                for (int n = 0; n < 2; ++n) acc[a][b][m][n] = (f32x4){0.f, 0.f, 0.f, 0.f};
    bf16x8 At[4][2], B0[2][2], B1[2][2];
    const char* cA = (const char*)g.A + (size_t)cur.pm * tstep; const char* cB = (const char*)g.Bt + (size_t)cur.pn * tstep;
    S.a_ready(cur);
    if constexpr (SP2) {
        PG8_STAGE(PG8_SB(0, 0), cB, voffB); PG8_STAGE(PG8_SB(0, 1), cB + hstep, voffB); PG8_STAGE(PG8_SA(0, 0), cA, voffA); PG8_STAGE(PG8_SA(0, 1), cA + hstep, voffA);
        if (wr == 1) PG8_BAR;
        PG8_WAIT_V(2); PG8_BAR;
        PG8_STAGE(PG8_SB(1, 0), cB + kstep, voffB); PG8_STAGE(PG8_SA(1, 0), cA + kstep, voffA); PG8_STAGE(PG8_SB(1, 1), cB + hstep + kstep, voffB);
        PG8_WAIT_V(6); PG8_BAR;
    } else {
        PG8_STAGE(PG8_SB(0, 0), cB, voffB); PG8_STAGE(PG8_SA(0, 0), cA, voffA); PG8_STAGE(PG8_SB(0, 1), cB + hstep, voffB); PG8_STAGE(PG8_SA(0, 1), cA + hstep, voffA);
        if (wr == 1) PG8_BAR;
        PG8_WAIT_V(4); PG8_BAR;
        PG8_STAGE(PG8_SB(1, 0), cB + kstep, voffB); PG8_STAGE(PG8_SA(1, 0), cA + kstep, voffA); PG8_STAGE(PG8_SB(1, 1), cB + hstep + kstep, voffB);
        PG8_WAIT_V(6); PG8_BAR;
    }
    for (;;) {
        const bool has_next = S.next(ui + 1, nxt);
        const char* nA = has_next ? (const char*)g.A + (size_t)nxt.pm * tstep : cA; const char* nB = has_next ? (const char*)g.Bt + (size_t)nxt.pn * tstep : cB;
        for (int t = 0; t < nt; t += 2) {
            const bool last = (t == nt - 2);
            const char* a1 = cA + (size_t)(t + 1) * kstep;
            const char* a2 = last ? nA : cA + (size_t)(t + 2) * kstep; const char* b2 = last ? nB : cB + (size_t)(t + 2) * kstep;
            const char* a3 = a2 + kstep; const char* b3 = b2 + kstep;
            if (last && has_next) S.a_ready(nxt);
            if constexpr (SP2) {
            PG8_LDB(B0, 0, 0); PG8_LDB(B1, 0, 1); PG8_SCHED; PG8_LDA(At, 0, 0); PG8_STAGE(PG8_SA(1, 1), a1 + hstep, voffA);
            PG8_WAIT_V(8); PG8_WAIT_L(0); PG8_BAR; PG8_MMA(0, 0, At, B0); PG8_MMA(0, 1, At, B1); PG8_BAR; PG8_SCHED;
            PG8_LDA(At, 0, 1); PG8_STAGE(PG8_SB(0, 0), b2, voffB); PG8_STAGE(PG8_SB(0, 1), b2 + hstep, voffB); PG8_STAGE(PG8_SA(0, 0), a2, voffA);
            PG8_WAIT_V(8); PG8_WAIT_L(0); PG8_BAR; PG8_MMA(1, 0, At, B0); PG8_MMA(1, 1, At, B1); PG8_BAR; PG8_SCHED;
            PG8_LDB(B0, 1, 0); PG8_LDB(B1, 1, 1); PG8_SCHED; PG8_LDA(At, 1, 0); PG8_STAGE(PG8_SA(0, 1), a2 + hstep, voffA);
            PG8_WAIT_V(8); PG8_WAIT_L(0); PG8_BAR; PG8_MMA(0, 0, At, B0); PG8_MMA(0, 1, At, B1); PG8_BAR; PG8_SCHED;
            PG8_LDA(At, 1, 1); PG8_STAGE(PG8_SB(1, 0), b3, voffB); PG8_STAGE(PG8_SB(1, 1), b3 + hstep, voffB); PG8_STAGE(PG8_SA(1, 0), a3, voffA);
            PG8_WAIT_V(8); PG8_WAIT_L(0); PG8_BAR; PG8_MMA(1, 0, At, B0); PG8_MMA(1, 1, At, B1); PG8_BAR; PG8_SCHED;
            } else {
            PG8_LDB(B0, 0, 0); PG8_SCHED; PG8_LDA(At, 0, 0); PG8_STAGE(PG8_SA(1, 1), a1 + hstep, voffA);
            PG8_WAIT_L(8); PG8_BAR; PG8_WAIT_L(0); PG8_MMA(0, 0, At, B0); PG8_BAR; PG8_SCHED;
            PG8_LDB(B1, 0, 1); PG8_STAGE(PG8_SB(0, 0), b2, voffB);
            PG8_BAR; PG8_WAIT_L(0); PG8_MMA(0, 1, At, B1); PG8_BAR;
            PG8_LDA(At, 0, 1); PG8_STAGE(PG8_SA(0, 0), a2, voffA);
            PG8_BAR; PG8_WAIT_L(0); PG8_MMA(1, 0, At, B0); PG8_BAR; PG8_SCHED;
            PG8_STAGE(PG8_SB(0, 1), b2 + hstep, voffB);
            PG8_WAIT_V(6); PG8_BAR; PG8_MMA(1, 1, At, B1); PG8_BAR;
            PG8_LDB(B0, 1, 0); PG8_SCHED; PG8_LDA(At, 1, 0); PG8_STAGE(PG8_SA(0, 1), a2 + hstep, voffA);
            PG8_WAIT_L(8); PG8_BAR; PG8_WAIT_L(0); PG8_MMA(0, 0, At, B0); PG8_BAR; PG8_SCHED;
            PG8_LDB(B1, 1, 1); PG8_STAGE(PG8_SB(1, 0), b3, voffB);
            PG8_BAR; PG8_WAIT_L(0); PG8_MMA(0, 1, At, B1); PG8_BAR;
            PG8_LDA(At, 1, 1); PG8_STAGE(PG8_SA(1, 0), a3, voffA);
            PG8_BAR; PG8_WAIT_L(0); PG8_MMA(1, 0, At, B0); PG8_BAR; PG8_SCHED;
            PG8_STAGE(PG8_SB(1, 1), b3 + hstep, voffB);
            PG8_WAIT_V(6); PG8_BAR; PG8_MMA(1, 1, At, B1); PG8_BAR;
            }
        }
        if constexpr (ALIGN_EPI) { if (wr == 0) PG8_BAR; }
        if constexpr (!Epi::AFTER_DRAIN) { E(acc, cur, wr, wc, fr, fq); S.done(cur); }
        if (!has_next) break;
#pragma unroll
        for (int a = 0; a < 2; ++a)
#pragma unroll
            for (int b = 0; b < 2; ++b)
#pragma unroll
                for (int m = 0; m < 4; ++m)
#pragma unroll
                    for (int n = 0; n < 2; ++n) acc[a][b][m][n] = (f32x4){0.f, 0.f, 0.f, 0.f};
        cur = nxt; cA = nA; cB = nB; ++ui;
        if constexpr (ALIGN_EPI) { if (wr == 1) PG8_BAR; }
    }
    PG8_WAIT_V(0);
    if constexpr (!ALIGN_EPI) { if (wr == 0) PG8_BAR; }
    PG8_BAR;
    if constexpr (Epi::AFTER_DRAIN) { E.fused(acc, cur, wr, wc, fr, fq, lds, wid, lane); S.done(cur); }
#undef PG8_SA
#undef PG8_SB
#undef PG8_STAGE
#undef PG8_LDA
#undef PG8_LDB
#undef PG8_MMA
#undef PG8_WAIT_V
#undef PG8_WAIT_L
#undef PG8_BAR
#undef PG8_SCHED
}
}


namespace mk {
using pg8::bf16_t; using pg8::bf16x8; using pg8::f32x4; using pg8::u32x4; using pg8::cvt_pk_bf16; using pg8::Unit;
typedef float f32x16 __attribute__((ext_vector_type(16)));
typedef unsigned u32x2 __attribute__((ext_vector_type(2)));
#define LAS __attribute__((address_space(3)))
#define LDS_WAIT() asm volatile("s_waitcnt lgkmcnt(0)" ::: "memory")

constexpr int S = 8192, D = 4096, NG = 128, DFF = 11008, UPW = 22016, PW = 6144;
constexpr int NC = 16, LC = 512;
constexpr float ALPHA = 1.189207115002721f;
constexpr float LN_EPS = 1e-5f;
constexpr float LAMBDA_INIT = 0.2f;
constexpr float LOG2E = 1.4426950408889634f;
constexpr int LDS_BYTES = 147456, LDS_XB = LDS_BYTES - 16;
constexpr size_t CTL_BAR = 4096;

constexpr size_t MiB = 1ull << 20;
constexpr size_t WS_CTL = 0, WS_XB = 1 * MiB, WS_WIN = 65 * MiB, WS_P = 129 * MiB, WS_VT = 225 * MiB, WS_YG = 257 * MiB, WS_MIXA = 289 * MiB,
                 WS_GH = 1 * MiB, WS_AH = 17 * MiB  , WS_WGLU = 353 * MiB, WS_WOUT = 361 * MiB, WS_WUP = 393 * MiB, WS_WDOWN = 565 * MiB,
                 WS_R1 = 651 * MiB, WS_H1B = 779 * MiB, WS_ACT = 843 * MiB, WS_SSMA = 1015 * MiB, WS_SSMAL = WS_SSMA + 65536, WS_SSMBB = WS_SSMAL + 65536,
                 WS_SSME = 1016 * MiB, WS_END = 1017 * MiB;

struct Params { const float* in[27]; float* out; unsigned char* ws; int ph_lo, ph_hi; };

__device__ __forceinline__ float wave_sum(float v) {
#pragma unroll
    for (int o = 1; o < 64; o <<= 1) v += __shfl_xor(v, o);
    return v;
}
__device__ __forceinline__ float bf_lo(unsigned w) { return __uint_as_float(w << 16); }
__device__ __forceinline__ float bf_hi(unsigned w) { return __uint_as_float(w & 0xffff0000u); }
__device__ __forceinline__ float gelu_tanh(float y) {
    const float inner = y * (1.0f + 0.044715f * y * y);
    const float e = __builtin_amdgcn_exp2f(inner * (-2.0f * 0.7978845608028654f * LOG2E));
    return y * __builtin_amdgcn_rcpf(1.0f + e);
}
__device__ __forceinline__ float sigmoidf_(float z) { return __builtin_amdgcn_rcpf(1.0f + __builtin_amdgcn_exp2f(-z * LOG2E)); }

template <int MODE> __device__ __forceinline__ int rowmap(int n) {
    if (MODE == 0) return n;
    const int isg = n >= DFF ? 1 : 0; const int c = isg ? n - DFF : n; return 256 * (c >> 7) + 128 * isg + (c & 127);
}
template <int MODE, bool NTST> __device__ __forceinline__ void transpose_tile(const float* __restrict__ W, int K, int N, bf16_t* __restrict__ WT, LAS float* scr, int item, int lane) {
    const int nblk = N / 64;
    const int kb = item / nblk, nb = item % nblk, k0 = kb * 64, n0 = nb * 64;
#pragma unroll 8
    for (int i = 0; i < 64; ++i) scr[i * 65 + lane] = __builtin_nontemporal_load(W + (size_t)(k0 + i) * N + n0 + lane);
    LDS_WAIT();
    const int c = lane & 7;
#pragma unroll
    for (int j = 0; j < 8; ++j) {
        const int n = (lane >> 3) + 8 * j; const LAS float* s = scr + (8 * c) * 65 + n;
        u32x4 o; o.x = cvt_pk_bf16(s[0], s[65]); o.y = cvt_pk_bf16(s[130], s[195]); o.z = cvt_pk_bf16(s[260], s[325]); o.w = cvt_pk_bf16(s[390], s[455]);
        if (NTST) __builtin_nontemporal_store(o, (u32x4*)(WT + (size_t)rowmap<MODE>(n0 + n) * K + k0 + 8 * c));
        else *(u32x4*)(WT + (size_t)rowmap<MODE>(n0 + n) * K + k0 + 8 * c) = o;
    }
    LDS_WAIT();
}

template <int MODE, bool NTST> __device__ __forceinline__ void transpose_tile_wide(const float* __restrict__ W, int K, int N, bf16_t* __restrict__ WT, LAS float* scr, int item, int lane) {
    const int nblk = N / 64;
    const int kb = item / nblk, nb = item % nblk, k0 = kb * 64, n0 = nb * 64;
    f32x4 v[16];
#pragma unroll
    for (int i = 0; i < 16; ++i) v[i] = __builtin_nontemporal_load((const f32x4*)(W + (size_t)(k0 + 4 * i + (lane >> 4)) * N + n0 + 4 * (lane & 15)));
#pragma unroll
    for (int i = 0; i < 16; ++i) { LAS float* d = scr + (4 * i + (lane >> 4)) * 65 + 4 * (lane & 15); d[0] = v[i][0]; d[1] = v[i][1]; d[2] = v[i][2]; d[3] = v[i][3]; }
    LDS_WAIT();
    const int c = lane & 7;
#pragma unroll
    for (int j = 0; j < 8; ++j) {
        const int n = (lane >> 3) + 8 * j; const LAS float* s = scr + (8 * c) * 65 + n;
        u32x4 o; o.x = cvt_pk_bf16(s[0], s[65]); o.y = cvt_pk_bf16(s[130], s[195]); o.z = cvt_pk_bf16(s[260], s[325]); o.w = cvt_pk_bf16(s[390], s[455]);
        if (NTST) __builtin_nontemporal_store(o, (u32x4*)(WT + (size_t)rowmap<MODE>(n0 + n) * K + k0 + 8 * c));
        else *(u32x4*)(WT + (size_t)rowmap<MODE>(n0 + n) * K + k0 + 8 * c) = o;
    }
    LDS_WAIT();
}

__device__ __forceinline__ void phase0(const Params& p, LAS unsigned char* lds) {
    const int tid = threadIdx.x, lane = tid & 63, wid = tid >> 6;
    const int gw = blockIdx.x * 8 + wid, nw = gridDim.x * 8;
    const int gt = blockIdx.x * 512 + tid, ngt = gridDim.x * 512;
    unsigned char* ws = p.ws;
    {
        const f32x4* x4 = (const f32x4*)p.in[0]; u32x4* xb = (u32x4*)(ws + WS_XB);
        const int n8 = S * D / 8;
        for (int i = gt; i < n8; i += ngt) {
            const f32x4 a = __builtin_nontemporal_load(x4 + 2 * i), b = __builtin_nontemporal_load(x4 + 2 * i + 1);
            u32x4 w; w.x = cvt_pk_bf16(a[0], a[1]); w.y = cvt_pk_bf16(a[2], a[3]); w.z = cvt_pk_bf16(b[0], b[1]); w.w = cvt_pk_bf16(b[2], b[3]);
            xb[i] = w;
        }
    }
    for (int i = gt; i < NG * 64; i += ngt) {
        const int g = i >> 6, n = i & 63;
        const double step = exp((double)p.in[2][g]);
        const double lr = (double)p.in[3][i], li = (double)p.in[4][i];
        const double mag = exp(lr * step); double sn, cs; sincos(li * step, &sn, &cs);
        const double are = mag * cs, aim = mag * sn;
        const double den = lr * lr + li * li, nr = are - 1.0, ni = aim;
        const double zre = (nr * lr + ni * li) / den, zim = (ni * lr - nr * li) / den;
        float* A = (float*)(ws + WS_SSMA); float* AL = (float*)(ws + WS_SSMAL); bf16_t* BB = (bf16_t*)(ws + WS_SSMBB);
        const float are_f = (float)are, aim_f = (float)aim;
        A[2 * i] = are_f; A[2 * i + 1] = aim_f;
        double pr = (double)are_f, pi = (double)aim_f;
#pragma unroll
        for (int s = 0; s < 9; ++s) { const double t = pr * pr - pi * pi; pi = 2.0 * pr * pi; pr = t; }
        AL[2 * i] = (float)pr; AL[2 * i + 1] = (float)pi;
        const float* bre = p.in[5] + (size_t)i * 16; const float* bim = p.in[6] + (size_t)i * 16;
        unsigned wre[8], wim[8];
#pragma unroll
        for (int h = 0; h < 16; h += 2) {
            const double br0 = bre[h], bi0 = bim[h], br1 = bre[h + 1], bi1 = bim[h + 1];
            wre[h >> 1] = cvt_pk_bf16((float)(zre * br0 - zim * bi0), (float)(zre * br1 - zim * bi1));
            wim[h >> 1] = cvt_pk_bf16((float)(zre * bi0 + zim * br0), (float)(zre * bi1 + zim * br1));
        }
        u32x4* dre = (u32x4*)(BB + ((size_t)g * 128 + n) * 16); u32x4* dim = (u32x4*)(BB + ((size_t)g * 128 + 64 + n) * 16);
        dre[0] = (u32x4){wre[0], wre[1], wre[2], wre[3]}; dre[1] = (u32x4){wre[4], wre[5], wre[6], wre[7]};
        dim[0] = (u32x4){wim[0], wim[1], wim[2], wim[3]}; dim[1] = (u32x4){wim[4], wim[5], wim[6], wim[7]};
    }
    if (blockIdx.x == 0) { unsigned* bw = (unsigned*)(ws + WS_CTL + CTL_BAR); for (int i = tid; i < 3456; i += 512) bw[i] = 0u; }
    if (blockIdx.x == 0 && wid == 0) {
        float s1 = p.in[12][lane] * p.in[13][lane] + p.in[12][lane + 64] * p.in[13][lane + 64];
        float s2 = p.in[14][lane] * p.in[15][lane] + p.in[14][lane + 64] * p.in[15][lane + 64];
        s1 = wave_sum(s1); s2 = wave_sum(s2);
        if (lane == 0) ((float*)(ws + WS_CTL))[0] = expf(s1) - expf(s2) + LAMBDA_INIT;
    }
    LAS float* scr = (LAS float*)(lds + wid * (64 * 65 * 4));
    constexpr int T_IN = (D / 64) * (8192 / 64), T_GLU = 32 * 32, T_OUT = 64 * 64, T_UP = (D / 64) * (UPW / 64), T_DN = (DFF / 64) * (D / 64);
    constexpr int E_IN = T_IN, E_GLU = E_IN + T_GLU, E_OUT = E_GLU + T_OUT, E_UP = E_OUT + T_UP, E_DN = E_UP + T_DN;
    for (int it = gw; it < E_UP; it += nw) {
        if (it < E_IN) transpose_tile<0, false>(p.in[1], D, 8192, (bf16_t*)(ws + WS_WIN), scr, it, lane);
        else if (it < E_GLU) transpose_tile<0, true>(p.in[10], 2048, 2048, (bf16_t*)(ws + WS_WGLU), scr, it - E_IN, lane);
        else if (it < E_OUT) transpose_tile<0, true>(p.in[18], D, D, (bf16_t*)(ws + WS_WOUT), scr, it - E_GLU, lane);
        else transpose_tile<1, true>(p.in[21], D, UPW, (bf16_t*)(ws + WS_WUP), scr, it - E_OUT, lane);
    }
}

template <bool SWAP16> struct EpiBf16PlainT {
    static constexpr bool PERM = true, AFTER_DRAIN = false;
    bf16_t* O; int ldc;
    __device__ __forceinline__ void operator()(const f32x4 (&acc)[2][2][4][2], const Unit& u, int wr, int wc, int fr, int fq) const {
        const int row0 = u.pm * 256 + wr * 64 + fr, col0 = u.pn * 256 + wc * 32 + 8 * fq;
#pragma unroll
        for (int ai = 0; ai < 2; ++ai)
#pragma unroll
            for (int m = 0; m < 4; ++m) { bf16_t* rowp = O + (size_t)(row0 + ai * 128 + m * 16) * ldc + col0;
#pragma unroll
                for (int bj = 0; bj < 2; ++bj) { const f32x4 v0 = acc[ai][bj][m][0], v1 = acc[ai][bj][m][1];
                    u32x4 w; w.x = cvt_pk_bf16(v0[0], v0[1]); w.y = cvt_pk_bf16(v0[2], v0[3]); w.z = cvt_pk_bf16(v1[0], v1[1]); w.w = cvt_pk_bf16(v1[2], v1[3]);
                    if (SWAP16 && (m & 1)) w = (u32x4){w.z, w.w, w.x, w.y};
                    *(u32x4*)(rowp + bj * 128) = w; } }
    }
};
typedef EpiBf16PlainT<false> EpiBf16Plain;
struct EpiGlu {
    static constexpr bool PERM = true, AFTER_DRAIN = false;
    bf16_t* O; int ldo; const bf16_t* YG; const float* bias;
    __device__ __forceinline__ void operator()(const f32x4 (&acc)[2][2][4][2], const Unit& u, int wr, int wc, int fr, int fq) const {
        const int row0 = u.pm * 256 + wr * 64 + fr, col0 = u.pn * 256 + wc * 32 + 8 * fq;
#pragma unroll
        for (int bj = 0; bj < 2; ++bj) {
            const f32x4 b0 = *(const f32x4*)(bias + col0 + bj * 128), b1 = *(const f32x4*)(bias + col0 + bj * 128 + 4);
#pragma unroll
            for (int ai = 0; ai < 2; ++ai)
#pragma unroll
                for (int m = 0; m < 4; ++m) { const size_t row = (size_t)(row0 + ai * 128 + m * 16);
                    const u32x4 y = *(const u32x4*)(YG + row * 2048 + col0 + bj * 128);
                    const f32x4 z0 = acc[ai][bj][m][0] + b0, z1 = acc[ai][bj][m][1] + b1;
                    u32x4 w;
                    w.x = cvt_pk_bf16(bf_lo(y.x) * sigmoidf_(z0[0]), bf_hi(y.x) * sigmoidf_(z0[1]));
                    w.y = cvt_pk_bf16(bf_lo(y.y) * sigmoidf_(z0[2]), bf_hi(y.y) * sigmoidf_(z0[3]));
                    w.z = cvt_pk_bf16(bf_lo(y.z) * sigmoidf_(z1[0]), bf_hi(y.z) * sigmoidf_(z1[1]));
                    w.w = cvt_pk_bf16(bf_lo(y.w) * sigmoidf_(z1[2]), bf_hi(y.w) * sigmoidf_(z1[3]));
                    *(u32x4*)(O + row * ldo + col0 + bj * 128) = w; } }
    }
};
struct EpiResX {
    static constexpr bool PERM = false, AFTER_DRAIN = false;
    bf16_t* CB; const bf16_t* baseB; int ld;
    __device__ __forceinline__ void operator()(const f32x4 (&acc)[2][2][4][2], const Unit& u, int wr, int wc, int fr, int fq) const {
        const int row0 = u.pm * 256 + wr * 64 + fr, col0 = u.pn * 256 + wc * 32 + 4 * fq;
#pragma unroll
        for (int ai = 0; ai < 2; ++ai)
#pragma unroll
            for (int m = 0; m < 4; ++m) { const size_t off = (size_t)(row0 + ai * 128 + m * 16) * ld + col0;
#pragma unroll
                for (int bj = 0; bj < 2; ++bj)
#pragma unroll
                    for (int n = 0; n < 2; ++n) { const u32x2 hb = *(const u32x2*)(baseB + off + bj * 128 + n * 16);
                        const f32x4 b = {bf_lo(hb.x), bf_hi(hb.x), bf_lo(hb.y), bf_hi(hb.y)};
                        const f32x4 r = b * ALPHA + acc[ai][bj][m][n];
                        u32x2 w; w.x = cvt_pk_bf16(r[0], r[1]); w.y = cvt_pk_bf16(r[2], r[3]); *(u32x2*)(CB + off + bj * 128 + n * 16) = w; } }
    }
};
struct EpiResB {
    static constexpr bool PERM = false, AFTER_DRAIN = false;
    bf16_t* CB; const bf16_t* baseB; int ld;
    __device__ __forceinline__ void operator()(const f32x4 (&acc)[2][2][4][2], const Unit& u, int wr, int wc, int fr, int fq) const {
        const int row0 = u.pm * 256 + wr * 64 + fr, col0 = u.pn * 256 + wc * 32 + 4 * fq;
#pragma unroll
        for (int ai = 0; ai < 2; ++ai)
#pragma unroll
            for (int m = 0; m < 4; ++m) { const size_t off = (size_t)(row0 + ai * 128 + m * 16) * ld + col0;
#pragma unroll
                for (int bj = 0; bj < 2; ++bj)
#pragma unroll
                    for (int n = 0; n < 2; ++n) { const u32x2 hb = *(const u32x2*)(baseB + off + bj * 128 + n * 16);
                        const f32x4 b = {bf_lo(hb.x), bf_hi(hb.x), bf_lo(hb.y), bf_hi(hb.y)};
                        const f32x4 r = b * ALPHA + acc[ai][bj][m][n];
                        u32x2 w; w.x = cvt_pk_bf16(r[0], r[1]); w.y = cvt_pk_bf16(r[2], r[3]); *(u32x2*)(CB + off + bj * 128 + n * 16) = w; } }
    }
};
struct EpiConvGate {
    static constexpr bool PERM = true, AFTER_DRAIN = false;
    bf16_t* ACT; bf16_t* GH; bf16_t* AH; const float* cw; const float* cb;
    __device__ __forceinline__ void operator()(f32x4 (&acc)[2][2][4][2], const Unit& u, int wr, int wc, int fr, int fq) const {
        const int ch0 = u.pn * 128 + wc * 32 + 8 * fq;
#pragma unroll
        for (int ai = 0; ai < 2; ++ai) {
            const int strip = 4 * u.pm + 2 * ai + wr;
            if (fr >= 14) { const f32x4 v0 = acc[ai][1][3][0], v1 = acc[ai][1][3][1];
                u32x4 w; w.x = cvt_pk_bf16(v0[0], v0[1]); w.y = cvt_pk_bf16(v0[2], v0[3]); w.z = cvt_pk_bf16(v1[0], v1[1]); w.w = cvt_pk_bf16(v1[2], v1[3]);
                *(u32x4*)(GH + (size_t)(strip * 4 + (fr - 14)) * DFF + ch0) = w; }
            if (fr < 2) { const f32x4 v0 = acc[ai][1][0][0], v1 = acc[ai][1][0][1], a0 = acc[ai][0][0][0], a1 = acc[ai][0][0][1];
                u32x4 w; w.x = cvt_pk_bf16(v0[0], v0[1]); w.y = cvt_pk_bf16(v0[2], v0[3]); w.z = cvt_pk_bf16(v1[0], v1[1]); w.w = cvt_pk_bf16(v1[2], v1[3]);
                *(u32x4*)(GH + (size_t)(strip * 4 + 2 + fr) * DFF + ch0) = w;
                w.x = cvt_pk_bf16(a0[0], a0[1]); w.y = cvt_pk_bf16(a0[2], a0[3]); w.z = cvt_pk_bf16(a1[0], a1[1]); w.w = cvt_pk_bf16(a1[2], a1[3]);
                *(u32x4*)(AH + (size_t)(strip * 2 + fr) * DFF + ch0) = w; }
        }
#define DPPF(x, ctrl) __builtin_bit_cast(float, __builtin_amdgcn_update_dpp(0, __builtin_bit_cast(int, (x)), (ctrl), 0xf, 0xf, true))
#pragma unroll
        for (int n = 0; n < 2; ++n) {
            const f32x4 w0v = *(const f32x4*)(cw + ch0 + 4 * n), w1v = *(const f32x4*)(cw + DFF + ch0 + 4 * n), w2v = *(const f32x4*)(cw + 2 * DFF + ch0 + 4 * n), bv = *(const f32x4*)(cb + ch0 + 4 * n);
#pragma unroll
            for (int e = 0; e < 4; ++e) {
                const float w0 = w0v[e], w1 = w1v[e], w2 = w2v[e], bb = bv[e];
#pragma unroll
                for (int ai = 0; ai < 2; ++ai) {
#pragma unroll
                    for (int m = 0; m < 4; ++m) {
                        const float g = acc[ai][1][m][n][e];
                        float g1 = DPPF(g, 0x111), g2 = DPPF(g, 0x112);
                        if (m > 0) { const float gp = acc[ai][1][m - 1][n][e]; g1 += DPPF(gp, 0x10F); g2 += DPPF(gp, 0x10E); }
                        const float gc = bb + w0 * g2 + w1 * g1 + w2 * g;
                        acc[ai][0][m][n][e] = gc * sigmoidf_(gc) * acc[ai][0][m][n][e];
                    }
                }
            }
        }
#undef DPPF
        const int row0 = u.pm * 256 + wr * 64 + fr;
#pragma unroll
        for (int ai = 0; ai < 2; ++ai)
#pragma unroll
            for (int m = 0; m < 4; ++m) { const f32x4 v0 = acc[ai][0][m][0], v1 = acc[ai][0][m][1];
                u32x4 w; w.x = cvt_pk_bf16(v0[0], v0[1]); w.y = cvt_pk_bf16(v0[2], v0[3]); w.z = cvt_pk_bf16(v1[0], v1[1]); w.w = cvt_pk_bf16(v1[2], v1[3]);
                *(u32x4*)(ACT + (size_t)(row0 + ai * 128 + m * 16) * DFF + ch0) = w; }
    }
};

template <bool OUTF> __device__ __forceinline__ void ln_rows(bf16_t* RB, float* OF, const float* gam, const float* bet) {
    const int lane = threadIdx.x & 63, gw = blockIdx.x * 8 + (threadIdx.x >> 6), nw = gridDim.x * 8;
    for (int row = gw; row < S; row += nw) {
        u32x2* r2 = (u32x2*)(RB + (size_t)row * D) + lane;
        f32x4 v[16]; float s = 0.f;
#pragma unroll
        for (int j = 0; j < 16; ++j) { const u32x2 w = r2[64 * j]; v[j] = (f32x4){bf_lo(w.x), bf_hi(w.x), bf_lo(w.y), bf_hi(w.y)}; s += (v[j][0] + v[j][1]) + (v[j][2] + v[j][3]); }
        const float mean = wave_sum(s) * (1.0f / D); float q = 0.f;
#pragma unroll
        for (int j = 0; j < 16; ++j) { v[j] = v[j] - mean; q += (v[j][0] * v[j][0] + v[j][1] * v[j][1]) + (v[j][2] * v[j][2] + v[j][3] * v[j][3]); }
        const float rstd = 1.0f / sqrtf(wave_sum(q) * (1.0f / D) + LN_EPS);
#pragma unroll
        for (int j = 0; j < 16; ++j) {
            const f32x4 g = ((const f32x4*)gam)[64 * j + lane], b = ((const f32x4*)bet)[64 * j + lane];
            const f32x4 o = v[j] * rstd * g + b;
            if (OUTF) __builtin_nontemporal_store(o, (f32x4*)(OF + (size_t)row * D) + 64 * j + lane);
            else { u32x2 w; w.x = cvt_pk_bf16(o[0], o[1]); w.y = cvt_pk_bf16(o[2], o[3]); r2[64 * j] = w; }
        }
    }
}

template <int PASS> __device__ __forceinline__ void ssm_pass(const Params& p, LAS unsigned char* lds) {
    const int tid = threadIdx.x, lane = tid & 63, wid = tid >> 6, l15 = lane & 15, q4 = lane >> 4;
    const int gw = blockIdx.x * 8 + wid, nw = gridDim.x * 8;
    unsigned char* ws = p.ws;
    const bf16_t* P = (const bf16_t*)(ws + WS_P);
    const float* A = (const float*)(ws + WS_SSMA); const float* AL = (const float*)(ws + WS_SSMAL); const bf16_t* BB = (const bf16_t*)(ws + WS_SSMBB);
    float* E = (float*)(ws + WS_SSME); bf16_t* YG = (bf16_t*)(ws + WS_YG);
    LAS unsigned char* bu = lds + wid * (16 * 528);
    for (int item = gw; item < NG * NC; item += nw) {
        const int g = item / NC, c = item % NC;
        const float are = A[2 * (g * 64 + lane)], aim = A[2 * (g * 64 + lane) + 1];
        bf16x8 bbf[8];
#pragma unroll
        for (int blk = 0; blk < 8; ++blk) {
            bbf[blk] = (bf16x8){0, 0, 0, 0, 0, 0, 0, 0};
            if (q4 < 2) bbf[blk] = *(const bf16x8*)(BB + ((size_t)g * 128 + 16 * blk + l15) * 16 + 8 * q4);
        }
        bf16x8 cf[4]; f32x4 dsk = {0.f, 0.f, 0.f, 0.f};
        if (PASS == 2) {
#pragma unroll
            for (int ks = 0; ks < 4; ++ks) {
                const float* src = (ks < 2 ? p.in[7] : p.in[8]) + ((size_t)g * 16 + l15) * 64 + 32 * (ks & 1) + 8 * q4;
                const f32x4 a = *(const f32x4*)src, b = *(const f32x4*)(src + 4); const float sg = ks < 2 ? 1.0f : -1.0f;
                u32x4 w; w.x = cvt_pk_bf16(sg * a[0], sg * a[1]); w.y = cvt_pk_bf16(sg * a[2], sg * a[3]); w.z = cvt_pk_bf16(sg * b[0], sg * b[1]); w.w = cvt_pk_bf16(sg * b[2], sg * b[3]);
                cf[ks] = *(bf16x8*)&w;
            }
            dsk = *(const f32x4*)(p.in[9] + g * 16 + 4 * q4);
        }
        float hre = 0.f, him = 0.f;
        if (PASS == 2) {
            const float alr = AL[2 * (g * 64 + lane)], ali = AL[2 * (g * 64 + lane) + 1];
            for (int cc = 0; cc < c; ++cc) {
                const float er = E[((size_t)g * NC + cc) * 128 + lane], ei = E[((size_t)g * NC + cc) * 128 + 64 + lane];
                const float nr = alr * hre - ali * him + er, ni = alr * him + ali * hre + ei; hre = nr; him = ni;
            }
        }
        const int t0 = c * LC;
        for (int tile = 0; tile < LC / 16; ++tile) {
            const int tb = t0 + 16 * tile;
            bf16x8 uf = (bf16x8){0, 0, 0, 0, 0, 0, 0, 0};
            if (q4 < 2) uf = *(const bf16x8*)(P + (size_t)(tb + l15) * PW + g * 16 + 8 * q4);
#pragma unroll
            for (int blk = 0; blk < 8; ++blk) {
                f32x4 acc = {0.f, 0.f, 0.f, 0.f};
                acc = __builtin_amdgcn_mfma_f32_16x16x32_bf16(bbf[blk], uf, acc, 0, 0, 0);
                *(LAS f32x4*)(bu + l15 * 528 + (16 * blk + 4 * q4) * 4) = acc;
            }
            LDS_WAIT();
#pragma unroll
            for (int t = 0; t < 16; ++t) {
                const float br = *(const LAS float*)(bu + t * 528 + lane * 4), bi = *(const LAS float*)(bu + t * 528 + 256 + lane * 4);
                const float nr = are * hre - aim * him + br, ni = are * him + aim * hre + bi; hre = nr; him = ni;
                if (PASS == 2) {
                    const unsigned w = cvt_pk_bf16(hre, him);
                    *(LAS unsigned short*)(bu + t * 528 + lane * 2) = (unsigned short)(w & 0xffffu);
                    *(LAS unsigned short*)(bu + t * 528 + 128 + lane * 2) = (unsigned short)(w >> 16);
                }
            }
            if (PASS == 2) {
                LDS_WAIT();
                f32x4 y = {0.f, 0.f, 0.f, 0.f};
#pragma unroll
                for (int ks = 0; ks < 4; ++ks) {
                    const bf16x8 hb = *(const LAS bf16x8*)(bu + l15 * 528 + ks * 64 + q4 * 16);
                    y = __builtin_amdgcn_mfma_f32_16x16x32_bf16(cf[ks], hb, y, 0, 0, 0);
                }
                const u32x2 uu = *(const u32x2*)(P + (size_t)(tb + l15) * PW + g * 16 + 4 * q4);
                const float y0 = gelu_tanh(y[0] + dsk[0] * bf_lo(uu.x)), y1 = gelu_tanh(y[1] + dsk[1] * bf_hi(uu.x));
                const float y2 = gelu_tanh(y[2] + dsk[2] * bf_lo(uu.y)), y3 = gelu_tanh(y[3] + dsk[3] * bf_hi(uu.y));
                u32x2 w; w.x = cvt_pk_bf16(y0, y1); w.y = cvt_pk_bf16(y2, y3);
                *(u32x2*)(YG + (size_t)(tb + l15) * 2048 + g * 16 + 4 * q4) = w;
                LDS_WAIT();
            }
        }
        if (PASS == 1) { E[((size_t)g * NC + c) * 128 + lane] = hre; E[((size_t)g * NC + c) * 128 + 64 + lane] = him; }
    }
}

constexpr int AT_KB = 64 * 512, AT_VB = 256 * 128, AT_STAGE = AT_KB + AT_VB, AT_TBL = 2 * AT_STAGE, AT_XROW = 1040;
__device__ __forceinline__ int t5_bucket(int rel) {
    const int n = rel < 0 ? -rel : rel; int b;
    if (n < 8) b = n; else if (n < 12) b = 8; else if (n < 16) b = 9; else if (n < 23) b = 10; else if (n < 32) b = 11; else if (n < 46) b = 12; else if (n < 64) b = 13; else if (n < 91) b = 14; else b = 15;
    return b + (rel > 0 ? 16 : 0);
}
__device__ __forceinline__ void attn_item(const Params& p, LAS unsigned char* lds, int head, int j) {
    int tid_ = threadIdx.x; asm volatile("" : "+v"(tid_));
    const int tid = tid_, lane = tid & 63, wid = __builtin_amdgcn_readfirstlane(tid >> 6), l31 = lane & 31, half = lane >> 5;
    const int rg = wid >> 1, c = wid & 1;
    unsigned char* ws = p.ws;
    const bf16_t* P = (const bf16_t*)(ws + WS_P); const bf16_t* VT = (const bf16_t*)(ws + WS_VT); bf16_t* MIXA = (bf16_t*)(ws + WS_MIXA);
    const float lam = ((const float*)(ws + WS_CTL))[0];
    const int q0 = 128 * j, nkt = 2 * j + 2;
    LAS float* tbl = (LAS float*)(lds + AT_TBL);
    if (tid < 320) tbl[tid] = p.in[17][t5_bucket(tid - 256) * 8 + head] * LOG2E;
    const float bfar = p.in[17][15 * 8 + head] * LOG2E;
    const float CS = 0.08838834764831845f * LOG2E;
    const unsigned qoff0 = (unsigned)(((32 * rg + l31) * PW + c * 128 + 8 * half) * 2);
    const char* qbase = (const char*)(P + (size_t)q0 * PW + 2048 + head * 256);
    bf16x8 qf[8];
#pragma unroll
    for (int ks = 0; ks < 8; ++ks) qf[ks] = *(const bf16x8*)(qbase + qoff0 + 32 * ks);
    const char* kgb = (const char*)(P + 4096 + head * 256); const char* vgb = (const char*)(VT + (size_t)head * 256 * S);
#define AT_DMA(kt, buf) do { int ln = lane; asm volatile("" : "+v"(ln)); _Pragma("unroll") for (int i = 0; i < 4; ++i) { \
        const int n_ = 4 * wid + i, kr_ = 2 * n_ + (ln >> 5), kc_ = (ln & 31) ^ (kr_ & 15), vr_ = 8 * n_ + (ln >> 3), vc_ = (ln & 7) ^ ((vr_ >> 1) & 7); \
        const unsigned ko_ = (unsigned)(kr_ * PW + kc_ * 8) * 2u, vo_ = (unsigned)(vr_ * S + vc_ * 8) * 2u; \
        __builtin_amdgcn_global_load_lds((const unsigned*)(kgb + (size_t)(kt) * 64 * PW * 2 + ko_), (LAS unsigned*)(lds + (buf) * AT_STAGE + (4 * wid + i) * 1024), 16, 0, 0); \
        __builtin_amdgcn_global_load_lds((const unsigned*)(vgb + (size_t)(kt) * 128 + vo_), (LAS unsigned*)(lds + (buf) * AT_STAGE + AT_KB + (4 * wid + i) * 1024), 16, 0, 0); } } while (0)
#define AT_VMWAIT() asm volatile("s_waitcnt vmcnt(0)" ::: "memory")
    const int kbase0 = l31 * 512 + c * 256 + (((l31 & 14) | (half ^ (l31 & 1))) << 4);
    const int vbase0 = l31 * 128 + ((half ^ (l31 >> 4)) & 1) * 8 + (((l31 >> 1) & 7) << 4);
    const int xoff0 = (32 * rg + l31) * AT_XROW;
    f32x16 o[8];
#pragma unroll
    for (int db = 0; db < 8; ++db)
#pragma unroll
        for (int r = 0; r < 16; ++r) o[db][r] = 0.f;
    float m_ref = -__builtin_inff(), lsum = 0.f;
#define AT_BAR() do { asm volatile("" ::: "memory"); __builtin_amdgcn_s_barrier(); asm volatile("" ::: "memory"); } while (0)
#define AT_QK(hb) do { bf16x8 kf[8]; \
        _Pragma("unroll") for (int ks = 0; ks < 8; ++ks) kf[ks] = *(const LAS bf16x8*)(Kb + (kbase ^ (ks * 32)) + (hb) * 32 * 512); \
        _Pragma("unroll") for (int r = 0; r < 16; ++r) s[r] = 0.f; \
        _Pragma("unroll") for (int ks = 0; ks < 8; ++ks) s = __builtin_amdgcn_mfma_f32_32x32x16_bf16(kf[ks], qf[ks], s, 0, 0, 0); } while (0)
#define AT_SM(hb) do { \
        const bool near_ = kt >= nkt - 4; float mx; \
        if (near_) { const LAS float* tb = tbl + (kt * 64 + 32 * (hb) + 4 * half - (q0 + 32 * rg + l31) + 256); \
            _Pragma("unroll") for (int r = 0; r < 16; ++r) s[r] = s[r] * CS + tb[(r & 3) + 8 * (r >> 2)]; \
            mx = s[0]; \
            _Pragma("unroll") for (int r = 1; r < 16; ++r) mx = fmaxf(mx, s[r]); \
        } else { mx = s[0]; \
            _Pragma("unroll") for (int r = 1; r < 16; ++r) mx = fmaxf(mx, s[r]); \
            mx = mx * CS + bfar; }                                            \
        mx = fmaxf(mx, __shfl_xor(mx, 32)); \
        if (__any(mx > m_ref + 8.0f)) { \
            const float mn = fmaxf(m_ref, mx); const float al = __builtin_amdgcn_exp2f(m_ref - mn); m_ref = mn; lsum *= al; \
            _Pragma("unroll") for (int db = 0; db < 8; ++db) _Pragma("unroll") for (int r = 0; r < 16; ++r) o[db][r] *= al; } \
        float ps = 0.f; \
        if (near_) { _Pragma("unroll") for (int r = 0; r < 16; ++r) { s[r] = __builtin_amdgcn_exp2f(s[r] - m_ref); ps += s[r]; } } \
        else { const float bm_ = bfar - m_ref; _Pragma("unroll") for (int r = 0; r < 16; ++r) { s[r] = __builtin_amdgcn_exp2f(s[r] * CS + bm_); ps += s[r]; } } \
        lsum += ps; \
        { u32x4 w; \
          w.x = cvt_pk_bf16(s[0], s[1]); w.y = cvt_pk_bf16(s[2], s[3]); w.z = cvt_pk_bf16(s[4], s[5]); w.w = cvt_pk_bf16(s[6], s[7]); pf[0] = *(bf16x8*)&w; \
          w.x = cvt_pk_bf16(s[8], s[9]); w.y = cvt_pk_bf16(s[10], s[11]); w.z = cvt_pk_bf16(s[12], s[13]); w.w = cvt_pk_bf16(s[14], s[15]); pf[1] = *(bf16x8*)&w; } } while (0)
#define AT_VLOAD(hb, db_) do { int vb_ = vbase0 + (db_) * 4096; asm volatile("" : "+v"(vb_)); _Pragma("unroll") for (int s2 = 0; s2 < 2; ++s2) { \
        const u32x2 lo_ = *(const LAS u32x2*)(Vb + (vb_ ^ ((2 * (hb) + s2) * 32))), hi_ = *(const LAS u32x2*)(Vb + (vb_ ^ ((2 * (hb) + s2) * 32 + 16))); \
        vf[(db_) & 1][s2] = (u32x4){lo_.x, lo_.y, hi_.x, hi_.y}; } } while (0)
#define AT_PV(hb) do { u32x4 vf[2][2]; AT_VLOAD(hb, 0); \
        _Pragma("unroll") for (int db = 0; db < 8; ++db) { \
            if (db + 1 < 8) AT_VLOAD(hb, db + 1); \
            o[db] = __builtin_amdgcn_mfma_f32_32x32x16_bf16(*(bf16x8*)&vf[db & 1][0], pf[0], o[db], 0, 0, 0); \
            o[db] = __builtin_amdgcn_mfma_f32_32x32x16_bf16(*(bf16x8*)&vf[db & 1][1], pf[1], o[db], 0, 0, 0); } } while (0)
    AT_DMA(0, 0); AT_VMWAIT();
    __syncthreads();
    if (wid >= 4) AT_BAR();
    f32x16 s; bf16x8 pf[2];
#pragma unroll
    for (int r = 0; r < 16; ++r) s[r] = 0.f;
    pf[0] = (bf16x8){0, 0, 0, 0, 0, 0, 0, 0}; pf[1] = pf[0];
    for (int kt = 0; kt < nkt; ++kt) {
        const int cur = kt & 1;
        const bool more = kt + 1 < nkt;
        const bool active = !(kt == 2 * j + 1 && rg < 2);
        const LAS unsigned char* Kb = lds + cur * AT_STAGE; const LAS unsigned char* Vb = Kb + AT_KB;
        int kbase = kbase0; asm volatile("" : "+v"(kbase));
        if (active) { AT_QK(0); AT_SM(0); }
        AT_BAR();
        if (more) AT_DMA(kt + 1, cur ^ 1);
        if (active) { AT_PV(0); AT_QK(1); }
        AT_BAR();
        if (active) { AT_SM(1); }
        AT_VMWAIT();
        AT_BAR();
        if (active) { AT_PV(1); }
        AT_BAR();
    }
    if (wid < 4) AT_BAR();
#undef AT_BAR
#undef AT_QK
#undef AT_SM
#undef AT_VLOAD
#undef AT_PV
#undef AT_DMA
    const float ltot = lsum + __shfl_xor(lsum, 32);
    const float inv = 1.0f / ltot;
    int xo = xoff0 + 16 * half; asm volatile("" : "+v"(xo));
    if (c == 1) {
        LAS unsigned char* xrow = lds + xo;
        const float f = lam * inv;
#pragma unroll
        for (int db = 0; db < 8; ++db)
#pragma unroll
            for (int r4 = 0; r4 < 4; ++r4) {
                f32x4 v = {o[db][4 * r4] * f, o[db][4 * r4 + 1] * f, o[db][4 * r4 + 2] * f, o[db][4 * r4 + 3] * f};
                *(LAS f32x4*)(xrow + (32 * db + 8 * r4) * 4) = v;
            }
    }
    __syncthreads();
    if (c == 0) {
        asm volatile("" : "+v"(xo));
        LAS unsigned char* xrow = lds + xo;
        float ss = 0.f;
#pragma unroll
        for (int db = 0; db < 8; ++db)
#pragma unroll
            for (int r4 = 0; r4 < 4; ++r4) {
                const f32x4 x1 = *(const LAS f32x4*)(xrow + (32 * db + 8 * r4) * 4);
#pragma unroll
                for (int e = 0; e < 4; ++e) { const float x = o[db][4 * r4 + e] * inv - x1[e]; o[db][4 * r4 + e] = x; ss += x * x; }
                if ((r4 & 1) == 1) __builtin_amdgcn_sched_barrier(0);
            }
        ss += __shfl_xor(ss, 32);
        const float rms = (1.0f - LAMBDA_INIT) / sqrtf(ss * (1.0f / 256.0f) + LN_EPS);
        LDS_WAIT();
        int xb = xoff0 + 8 * half; asm volatile("" : "+v"(xb));
        LAS unsigned char* brow = lds + xb;
        int go = 16 * half; asm volatile("" : "+v"(go));
        const char* gp = (const char*)p.in[16] + go;
#pragma unroll
        for (int db = 0; db < 8; ++db)
#pragma unroll
            for (int r4 = 0; r4 < 4; ++r4) {
                const f32x4 g = *(const f32x4*)(gp + (32 * db + 8 * r4) * 4);
                u32x2 w; w.x = cvt_pk_bf16(o[db][4 * r4] * rms * g[0], o[db][4 * r4 + 1] * rms * g[1]); w.y = cvt_pk_bf16(o[db][4 * r4 + 2] * rms * g[2], o[db][4 * r4 + 3] * rms * g[3]);
                *(LAS u32x2*)(brow + (32 * db + 8 * r4) * 2) = w;
                if ((r4 & 1) == 1) __builtin_amdgcn_sched_barrier(0);
            }
    }
    __syncthreads();
    {
        int co = (tid >> 5) * AT_XROW + (tid & 31) * 16; asm volatile("" : "+v"(co));
        unsigned mo = (unsigned)(((tid >> 5) * D + (tid & 31) * 8) * 2); asm volatile("" : "+v"(mo));
        char* mb = (char*)(MIXA + (size_t)q0 * D + 2048 + head * 256);
#pragma unroll
        for (int i = 0; i < 8; ++i) {
            const u32x4 w = *(const LAS u32x4*)(lds + co + i * 16 * AT_XROW);
            *(u32x4*)(mb + mo + (size_t)i * 16 * D * 2) = w;
        }
    }
    __syncthreads();
}
__device__ __forceinline__ void attn_phase(const Params& p, LAS unsigned char* lds) {
    for (int pr = blockIdx.x; pr < 256; pr += gridDim.x) {
        const int head = pr & 7, i = pr >> 3;
        attn_item(p, lds, head, 63 - i);
        attn_item(p, lds, head, i);
    }
}

__device__ __forceinline__ void unpack8(const u32x4 v, float (&f)[8]) { f[0] = bf_lo(v.x); f[1] = bf_hi(v.x); f[2] = bf_lo(v.y); f[3] = bf_hi(v.y); f[4] = bf_lo(v.z); f[5] = bf_hi(v.z); f[6] = bf_lo(v.w); f[7] = bf_hi(v.w); }
__device__ __forceinline__ void conv_fix(const Params& p) {
    const bf16_t* GH = (const bf16_t*)(p.ws + WS_GH); const bf16_t* AH = (const bf16_t*)(p.ws + WS_AH); bf16_t* ACT = (bf16_t*)(p.ws + WS_ACT);
    const float* cw = p.in[22]; const float* cb = p.in[23];
    const int gt = blockIdx.x * 512 + threadIdx.x, ngt = gridDim.x * 512;
    constexpr int NV = DFF / 8, NSTRIP = S / 64;
    for (int it = gt; it < NV * NSTRIP; it += ngt) {
        const int cv = it % NV, st = it / NV, ch = cv * 8;
        float gm2[8], gm1[8], g0[8], g1[8], a0[8], a1[8];
#pragma unroll
        for (int e = 0; e < 8; ++e) { gm2[e] = 0.f; gm1[e] = 0.f; }
        if (st > 0) { unpack8(*(const u32x4*)(GH + (size_t)((st - 1) * 4 + 0) * DFF + ch), gm2); unpack8(*(const u32x4*)(GH + (size_t)((st - 1) * 4 + 1) * DFF + ch), gm1); }
        unpack8(*(const u32x4*)(GH + (size_t)(st * 4 + 2) * DFF + ch), g0); unpack8(*(const u32x4*)(GH + (size_t)(st * 4 + 3) * DFF + ch), g1);
        unpack8(*(const u32x4*)(AH + (size_t)(st * 2 + 0) * DFF + ch), a0); unpack8(*(const u32x4*)(AH + (size_t)(st * 2 + 1) * DFF + ch), a1);
        float r0[8], r1[8];
#pragma unroll
        for (int e = 0; e < 8; ++e) {
            const float w0 = cw[ch + e], w1 = cw[DFF + ch + e], w2 = cw[2 * DFF + ch + e], bb = cb[ch + e];
            const float c0 = bb + w0 * gm2[e] + w1 * gm1[e] + w2 * g0[e], c1 = bb + w0 * gm1[e] + w1 * g0[e] + w2 * g1[e];
            r0[e] = c0 * sigmoidf_(c0) * a0[e]; r1[e] = c1 * sigmoidf_(c1) * a1[e];
        }
        u32x4 w; w.x = cvt_pk_bf16(r0[0], r0[1]); w.y = cvt_pk_bf16(r0[2], r0[3]); w.z = cvt_pk_bf16(r0[4], r0[5]); w.w = cvt_pk_bf16(r0[6], r0[7]);
        *(u32x4*)(ACT + (size_t)(st * 64) * DFF + ch) = w;
        w.x = cvt_pk_bf16(r1[0], r1[1]); w.y = cvt_pk_bf16(r1[2], r1[3]); w.z = cvt_pk_bf16(r1[4], r1[5]); w.w = cvt_pk_bf16(r1[6], r1[7]);
        *(u32x4*)(ACT + (size_t)(st * 64 + 1) * DFF + ch) = w;
    }
}

#define XB_TMO      128
#define XB_XCNT(j)  (256  + 64 * (j))
#define XB_XSUB(j)  (1280 + 64 * (j))
#define XB_XGEN(j)  (2304 + 64 * (j))
#define XB_TOP      3328
#define XB_TOPGEN   3392
#define XCD_BAR_WORDS 3456
#define XB_SPIN_CAP (1u << 18)

__device__ __forceinline__ unsigned xb_ld(unsigned* p)              { return __hip_atomic_load(p, __ATOMIC_RELAXED, __HIP_MEMORY_SCOPE_AGENT); }
__device__ __forceinline__ unsigned xb_add(unsigned* p, unsigned v) { return __hip_atomic_fetch_add(p, v, __ATOMIC_RELAXED, __HIP_MEMORY_SCOPE_AGENT); }
__device__ __forceinline__ unsigned xb_xcc_id() { return (unsigned)__builtin_amdgcn_s_getreg((3 << 11) | 20) & 0xFu; }
#define XB_SPIN(cond, bar) do { unsigned _sp = 0; while (cond) { __builtin_amdgcn_s_sleep(1); \
    if ((++_sp & 255u) == 0u) { if (xb_ld(&(bar)[XB_TMO])) break; if (_sp > XB_SPIN_CAP) { atomicAdd(&(bar)[XB_TMO], 1u); break; } } } } while (0)

struct XcdBarrier {
    unsigned* bar; unsigned x;
    volatile LAS unsigned* st;
};

__device__ __forceinline__ XcdBarrier xcd_barrier_post(unsigned* bar, volatile LAS unsigned* st) {
    XcdBarrier b; b.bar = bar; b.x = xb_xcc_id(); b.st = st;
    if (threadIdx.x == 0) (void)xb_add(&bar[XB_XCNT(b.x)], 1u);
    return b;
}
__device__ __forceinline__ void xcd_barrier_complete(unsigned* bar, unsigned x, unsigned& nloc, unsigned& nx) {
    const unsigned G = gridDim.x * gridDim.y * gridDim.z;
    unsigned sum, cnt, mine, sp = 0u;
    for (;;) {
        sum = 0u; cnt = 0u; mine = 0u;
#pragma unroll
        for (unsigned j = 0; j < 16; ++j) { const unsigned c = xb_ld(&bar[XB_XCNT(j)]); sum += c; cnt += (c > 0u) ? 1u : 0u; mine = (j == x) ? c : mine; }
        if (sum == G) break;
        __builtin_amdgcn_s_sleep(1);
        if ((++sp & 255u) == 0u) { if (xb_ld(&bar[XB_TMO])) break; if (sp > XB_SPIN_CAP) { atomicAdd(&bar[XB_TMO], 1u); break; } }
    }
    nloc = mine > 0u ? mine : 1u; nx = cnt > 0u ? cnt : 1u;
}

__device__ __forceinline__ void xcd_barrier(const XcdBarrier& b) {
    asm volatile("s_waitcnt vmcnt(0)" ::: "memory");
    __syncthreads();
    if (threadIdx.x == 0) {
        unsigned* bar = b.bar;
        __builtin_amdgcn_s_waitcnt(0);
        unsigned nloc = b.st[0], nx = b.st[1];
        if (nloc == 0u) { xcd_barrier_complete(bar, b.x, nloc, nx); b.st[0] = nloc; b.st[1] = nx; }
        const unsigned old = xb_add(&bar[XB_XSUB(b.x)], 1u);
        const unsigned gen = old / nloc;
        if (old + 1u == (gen + 1u) * nloc) {
            __builtin_amdgcn_fence(__ATOMIC_RELEASE, "agent");
            asm volatile("s_waitcnt vmcnt(0)" ::: "memory");
            const unsigned og = xb_add(&bar[XB_TOP], 1u);
            const unsigned tg = og / nx;
            if (og + 1u == (tg + 1u) * nx) xb_add(&bar[XB_TOPGEN], 1u);
            else XB_SPIN(xb_ld(&bar[XB_TOPGEN]) == tg, bar);
            __builtin_amdgcn_fence(__ATOMIC_ACQUIRE, "agent");
            xb_add(&bar[XB_XGEN(b.x)], 1u);
            asm volatile("s_waitcnt vmcnt(0)" ::: "memory");
        } else {
            XB_SPIN(xb_ld(&bar[XB_XGEN(b.x)]) == gen, bar);
            __builtin_amdgcn_fence(__ATOMIC_ACQUIRE, "agent");
            asm volatile("s_waitcnt vmcnt(0)" ::: "memory");
        }
    }
    __syncthreads();
}

#ifndef GEMM_SP2
#define GEMM_SP2 true
#endif
#ifndef GEMM_ALIGN_EPI
#define GEMM_ALIGN_EPI true
#endif
template <class Epi> __device__ __forceinline__ void run_gemm(LAS unsigned char* lds, const bf16_t* A, const bf16_t* Bt, int M, int N, int K, const Epi& E) {
    pg8::Gemm g{A, Bt, M, N, K}; pg8::StaticOrder So; So.init(M, N, (int)gridDim.x, (int)blockIdx.x);
    pg8::gemm_phase<Epi, pg8::StaticOrder, GEMM_ALIGN_EPI, GEMM_SP2>(lds, g, So, E);
}

__global__ void __launch_bounds__(512, 2) mega(Params p) {
    extern __shared__ __attribute__((aligned(16))) unsigned char shm[];
    LAS unsigned char* lds = (LAS unsigned char*)shm;
    cg::grid_group grid = cg::this_grid();
    unsigned char* ws = p.ws;
#ifndef PHMASK
#define PHMASK 0x7ff
#endif
#define IN(k) ((((PHMASK) >> (k)) & 1) && p.ph_lo <= (k) && (k) < p.ph_hi)
#define SEAM(k) do { if (IN(k) && IN((k) + 1)) xcd_barrier(xbar); } while (0)
    if (threadIdx.x < 4) ((volatile LAS unsigned*)(lds + LDS_XB))[threadIdx.x] = 0u;
    __syncthreads();
    if (IN(0)) phase0(p, lds);
    if (IN(0) && IN(1)) grid.sync();
    XcdBarrier xbar = xcd_barrier_post((unsigned*)(ws + WS_CTL + CTL_BAR), (volatile LAS unsigned*)(lds + LDS_XB));
    if (IN(1)) {
        run_gemm(lds, (const bf16_t*)(ws + WS_XB), (const bf16_t*)(ws + WS_WIN), S, PW, D, EpiBf16Plain{(bf16_t*)(ws + WS_P), PW});
        run_gemm(lds, (const bf16_t*)(ws + WS_WIN) + (size_t)PW * D, (const bf16_t*)(ws + WS_XB), 2048, S, D, EpiBf16PlainT<true>{(bf16_t*)(ws + WS_VT), S});
    }
    SEAM(1);
    if (IN(2)) ssm_pass<1>(p, lds);
    SEAM(2);
    if (IN(3)) {
#ifndef NO_ATT
        attn_phase(p, lds);
#endif
#ifndef NO_SSM2
        ssm_pass<2>(p, lds);
#endif
        __syncthreads(); }
    SEAM(3);
    if (IN(4)) run_gemm(lds, (const bf16_t*)(ws + WS_YG), (const bf16_t*)(ws + WS_WGLU), S, 2048, 2048, EpiGlu{(bf16_t*)(ws + WS_MIXA), D, (const bf16_t*)(ws + WS_YG), p.in[11]});
    SEAM(4);
    if (IN(5)) run_gemm(lds, (const bf16_t*)(ws + WS_MIXA), (const bf16_t*)(ws + WS_WOUT), S, D, D, EpiResX{(bf16_t*)(ws + WS_H1B), (const bf16_t*)(ws + WS_XB), D});
    SEAM(5);
    if (IN(6)) ln_rows<false>((bf16_t*)(ws + WS_H1B), nullptr, p.in[19], p.in[20]);
    SEAM(6);
    if (IN(7)) {
        run_gemm(lds, (const bf16_t*)(ws + WS_H1B), (const bf16_t*)(ws + WS_WUP), S, UPW, D, EpiConvGate{(bf16_t*)(ws + WS_ACT), (bf16_t*)(ws + WS_GH), (bf16_t*)(ws + WS_AH), p.in[22], p.in[23]});
        {
            const int nun = (S / 256) * (UPW / 256), G = (int)gridDim.x, rem = nun % G;
            const int sp0 = rem, nsp = G - rem;
            if ((int)blockIdx.x >= sp0) {
                const int wid = threadIdx.x >> 6, lane = threadIdx.x & 63;
                LAS float* scr = (LAS float*)(lds + wid * (64 * 65 * 4));
                constexpr int T_DN = (DFF / 64) * (D / 64);
                for (int it = ((int)blockIdx.x - sp0) * 8 + wid; it < T_DN; it += nsp * 8) transpose_tile_wide<0, true>(p.in[24], DFF, D, (bf16_t*)(ws + WS_WDOWN), scr, it, lane);
            }
        }
    }
    SEAM(7);
    if (IN(8)) conv_fix(p);
    SEAM(8);
    if (IN(9)) run_gemm(lds, (const bf16_t*)(ws + WS_ACT), (const bf16_t*)(ws + WS_WDOWN), S, D, DFF, EpiResB{(bf16_t*)(ws + WS_R1), (const bf16_t*)(ws + WS_H1B), D});
    SEAM(9);
    if (IN(10)) ln_rows<true>((bf16_t*)(ws + WS_R1), p.out, p.in[25], p.in[26]);
#undef IN
#undef SEAM
}
}

extern "C" void kernel_launch(void* const* d_in, const int* in_sizes, int n_in, void* d_out, int out_size, void* d_ws, size_t ws_size, hipStream_t stream) {
    static int grid = 0;
    if (grid == 0) {
        if (n_in != 27 || ws_size < mk::WS_END) { fprintf(stderr, "kernel_launch: unexpected inputs (n_in %d, ws %zu)\n", n_in, ws_size); grid = -1; return; }
        int dev = 0, cus = 0, per_cu = 0;
        (void)hipGetDevice(&dev); (void)hipDeviceGetAttribute(&cus, hipDeviceAttributeMultiprocessorCount, dev);
        if (hipFuncSetAttribute((const void*)mk::mega, hipFuncAttributeMaxDynamicSharedMemorySize, mk::LDS_BYTES) != hipSuccess) { fprintf(stderr, "kernel_launch: hipFuncSetAttribute failed\n"); grid = -1; return; }
        if (hipOccupancyMaxActiveBlocksPerMultiprocessor(&per_cu, (const void*)mk::mega, 512, mk::LDS_BYTES) != hipSuccess || per_cu < 1) { fprintf(stderr, "kernel_launch: occupancy query says %d\n", per_cu); per_cu = 1; }
        (void)hipGetLastError();
        grid = cus * 1;
        if (grid <= 0) grid = 256;
    }
    if (grid < 0) return;
    mk::Params p{};
    for (int i = 0; i < 27; ++i) p.in[i] = (const float*)d_in[i];
    p.out = (float*)d_out; p.ws = (unsigned char*)d_ws; p.ph_lo = 0; p.ph_hi = 11;
    void* args[] = {&p};
    const hipError_t e = hipLaunchCooperativeKernel((const void*)mk::mega, dim3(grid), dim3(512), args, mk::LDS_BYTES, stream);
    if (e != hipSuccess) fprintf(stderr, "kernel_launch: cooperative launch failed: %s (grid %d)\n", hipGetErrorString(e), grid);
}
```

```cpp
#include <hip/hip_runtime.h>
#include <hip/hip_cooperative_groups.h>
#include <cstdio>
namespace cg = cooperative_groups;
#include <hip/hip_runtime.h>
namespace pg8 {
#define PG8_LAS __attribute__((address_space(3)))
typedef unsigned short bf16_t;
typedef short bf16x8 __attribute__((ext_vector_type(8)));
typedef float f32x4 __attribute__((ext_vector_type(4)));
typedef unsigned u32x4 __attribute__((ext_vector_type(4)));
constexpr int BM = 256, BK = 64, HALF = 128, HTB = HALF * BK * 2  , STAGE_BYTES = 8 * HTB, NXCD = 8, WGM = 8;

__host__ __device__ __forceinline__ int lds_byte(int r, int c) { const int st = (r >> 4) * 2 + (c >> 5), rr = r & 15, cc = c & 31, ob = rr * 64 + cc * 2; return st * 1024 + (ob ^ (((ob >> 9) & 1) << 5)); }
__host__ __device__ __forceinline__ void stage_rc(int b, int& R, int& C) { const int st = b / 1024, sb = b % 1024, swz = sb ^ (((sb >> 9) & 1) << 5); R = (st >> 1) * 16 + swz / 64; C = (st & 1) * 32 + (swz % 64) / 2; }
__host__ __device__ __forceinline__ int perm32(int rho) { const int n = rho >> 4, i = rho & 15; return 8 * (i >> 2) + 4 * n + (i & 3); }

struct Unit { int pm, pn; };
struct Gemm { const bf16_t* A; const bf16_t* Bt; int M, N, K; };

struct StaticOrder {
    int nM, nN, nwg, G, c;
    __host__ __device__ void init(int M, int N, int G_, int c_) { nM = M / BM; nN = N / BM; nwg = nM * nN; G = G_; c = c_; }
    __host__ __device__ bool next(int i, Unit& u) const {
        const long L = (long)i * G + c; if (L >= nwg) return false;
        int wgid = (int)L; { const int q = nwg / NXCD, r = nwg % NXCD, xcd = wgid % NXCD, off = wgid / NXCD; wgid = (xcd < r ? xcd * (q + 1) : r * (q + 1) + (xcd - r) * q) + off; }
        const int nig = WGM * nN, gid = wgid / nig, fm = gid * WGM, gsz = (nM - fm) < WGM ? (nM - fm) : WGM;
        u.pm = fm + ((wgid % nig) % gsz); u.pn = (wgid % nig) / gsz; return true;
    }
    __device__ __forceinline__ void a_ready(const Unit&) const {}
    __device__ __forceinline__ void done(const Unit&) const {}
};
__device__ __forceinline__ unsigned cvt_pk_bf16(float lo, float hi) { unsigned r; asm volatile("v_cvt_pk_bf16_f32 %0, %1, %2" : "=v"(r) : "v"(lo), "v"(hi)); return r; }
template <class Epi, class Sched, bool ALIGN_EPI = false, bool SP2 = false>
__device__ __forceinline__ void gemm_phase(PG8_LAS unsigned char* lds, const Gemm g, const Sched& S, const Epi& E) {
    const int tid = threadIdx.x, wid = __builtin_amdgcn_readfirstlane(tid >> 6), lane = tid & 63, wr = wid >> 2, wc = wid & 3, fr = lane & 15, fq = lane >> 4;
    const int K = g.K, nt = K / BK;
    unsigned voffA[2], voffB[2];
#pragma unroll
    for (int i = 0; i < 2; ++i) { int R, C; stage_rc(tid * 16 + i * 8192, R, C); const int Rb = Epi::PERM ? ((R & ~31) + perm32(R & 31)) : R;
        voffA[i] = (unsigned)(R * K + C) * 2u; voffB[i] = (unsigned)(Rb * K + C) * 2u; }
    const size_t kstep = (size_t)(BK * 2);
    const size_t hstep = (size_t)HALF * K * 2;
    const size_t tstep = 2 * hstep;
    const unsigned ldsw = (unsigned)wid * 1024u;
    const int aoff = lds_byte(wr * 64 + fr, fq * 8), boff = lds_byte(wc * 32 + fr, fq * 8);
#define PG8_SA(b, h) (((b) * 2 + (h)) * HTB)
#define PG8_SB(b, h) ((4 + (b) * 2 + (h)) * HTB)
#define PG8_STAGE(bufoff, gbase, voff) do { _Pragma("unroll") for (int _i = 0; _i < 2; ++_i) \
        __builtin_amdgcn_global_load_lds((const unsigned*)((const char*)(gbase) + (voff)[_i]), (PG8_LAS unsigned*)(lds + (bufoff) + ldsw + _i * 8192), 16, 0, 0); } while (0)
#define PG8_LDA(dst, b, h) do { _Pragma("unroll") for (int m = 0; m < 4; ++m) _Pragma("unroll") for (int k = 0; k < 2; ++k) dst[m][k] = *(const PG8_LAS bf16x8*)(lds + PG8_SA(b, h) + aoff + m * 2048 + k * 1024); } while (0)
#define PG8_LDB(dst, b, h) do { _Pragma("unroll") for (int n = 0; n < 2; ++n) _Pragma("unroll") for (int k = 0; k < 2; ++k) dst[n][k] = *(const PG8_LAS bf16x8*)(lds + PG8_SB(b, h) + boff + n * 2048 + k * 1024); } while (0)
#define PG8_MMA(ai, bj, At, Bt) do { __builtin_amdgcn_s_setprio(1); _Pragma("unroll") for (int m = 0; m < 4; ++m) _Pragma("unroll") for (int n = 0; n < 2; ++n) _Pragma("unroll") for (int k = 0; k < 2; ++k) \
        acc[ai][bj][m][n] = __builtin_amdgcn_mfma_f32_16x16x32_bf16(Bt[n][k], At[m][k], acc[ai][bj][m][n], 0, 0, 0); __builtin_amdgcn_s_setprio(0); } while (0)
#define PG8_WAIT_V(n) asm volatile("s_waitcnt vmcnt(" #n ")" ::: "memory")
#define PG8_WAIT_L(n) asm volatile("s_waitcnt lgkmcnt(" #n ")" ::: "memory")
#define PG8_BAR __builtin_amdgcn_s_barrier()
#define PG8_SCHED __builtin_amdgcn_sched_barrier(0)
    Unit cur, nxt; int ui = 0;
    if (!S.next(0, cur)) return;
    f32x4 acc[2][2][4][2];
#pragma unroll
    for (int a = 0; a < 2; ++a)
#pragma unroll
        for (int b = 0; b < 2; ++b)
#pragma unroll
            for (int m = 0; m < 4; ++m)
#pragma unroll
                for (int n = 0; n < 2; ++n) acc[a][b][m][n] = (f32x4){0.f, 0.f, 0.f, 0.f};
    bf16x8 At[4][2], B0[2][2], B1[2][2];
    const char* cA = (const char*)g.A + (size_t)cur.pm * tstep; const char* cB = (const char*)g.Bt + (size_t)cur.pn * tstep;
    S.a_ready(cur);
    if constexpr (SP2) {
        PG8_STAGE(PG8_SB(0, 0), cB, voffB); PG8_STAGE(PG8_SB(0, 1), cB + hstep, voffB); PG8_STAGE(PG8_SA(0, 0), cA, voffA); PG8_STAGE(PG8_SA(0, 1), cA + hstep, voffA);
        if (wr == 1) PG8_BAR;
        PG8_WAIT_V(2); PG8_BAR;
        PG8_STAGE(PG8_SB(1, 0), cB + kstep, voffB); PG8_STAGE(PG8_SA(1, 0), cA + kstep, voffA); PG8_STAGE(PG8_SB(1, 1), cB + hstep + kstep, voffB);
        PG8_WAIT_V(6); PG8_BAR;
    } else {
        PG8_STAGE(PG8_SB(0, 0), cB, voffB); PG8_STAGE(PG8_SA(0, 0), cA, voffA); PG8_STAGE(PG8_SB(0, 1), cB + hstep, voffB); PG8_STAGE(PG8_SA(0, 1), cA + hstep, voffA);
        if (wr == 1) PG8_BAR;
        PG8_WAIT_V(4); PG8_BAR;
        PG8_STAGE(PG8_SB(1, 0), cB + kstep, voffB); PG8_STAGE(PG8_SA(1, 0), cA + kstep, voffA); PG8_STAGE(PG8_SB(1, 1), cB + hstep + kstep, voffB);
        PG8_WAIT_V(6); PG8_BAR;
    }
    for (;;) {
        const bool has_next = S.next(ui + 1, nxt);
        const char* nA = has_next ? (const char*)g.A + (size_t)nxt.pm * tstep : cA; const char* nB = has_next ? (const char*)g.Bt + (size_t)nxt.pn * tstep : cB;
        for (int t = 0; t < nt; t += 2) {
            const bool last = (t == nt - 2);
            const char* a1 = cA + (size_t)(t + 1) * kstep;
            const char* a2 = last ? nA : cA + (size_t)(t + 2) * kstep; const char* b2 = last ? nB : cB + (size_t)(t + 2) * kstep;
            const char* a3 = a2 + kstep; const char* b3 = b2 + kstep;
            if (last && has_next) S.a_ready(nxt);
            if constexpr (SP2) {
            PG8_LDB(B0, 0, 0); PG8_LDB(B1, 0, 1); PG8_SCHED; PG8_LDA(At, 0, 0); PG8_STAGE(PG8_SA(1, 1), a1 + hstep, voffA);
            PG8_WAIT_V(8); PG8_WAIT_L(0); PG8_BAR; PG8_MMA(0, 0, At, B0); PG8_MMA(0, 1, At, B1); PG8_BAR; PG8_SCHED;
            PG8_LDA(At, 0, 1); PG8_STAGE(PG8_SB(0, 0), b2, voffB); PG8_STAGE(PG8_SB(0, 1), b2 + hstep, voffB); PG8_STAGE(PG8_SA(0, 0), a2, voffA);
            PG8_WAIT_V(8); PG8_WAIT_L(0); PG8_BAR; PG8_MMA(1, 0, At, B0); PG8_MMA(1, 1, At, B1); PG8_BAR; PG8_SCHED;
            PG8_LDB(B0, 1, 0); PG8_LDB(B1, 1, 1); PG8_SCHED; PG8_LDA(At, 1, 0); PG8_STAGE(PG8_SA(0, 1), a2 + hstep, voffA);
            PG8_WAIT_V(8); PG8_WAIT_L(0); PG8_BAR; PG8_MMA(0, 0, At, B0); PG8_MMA(0, 1, At, B1); PG8_BAR; PG8_SCHED;
            PG8_LDA(At, 1, 1); PG8_STAGE(PG8_SB(1, 0), b3, voffB); PG8_STAGE(PG8_SB(1, 1), b3 + hstep, voffB); PG8_STAGE(PG8_SA(1, 0), a3, voffA);
            PG8_WAIT_V(8); PG8_WAIT_L(0); PG8_BAR; PG8_MMA(1, 0, At, B0); PG8_MMA(1, 1, At, B1); PG8_BAR; PG8_SCHED;
            } else {
            PG8_LDB(B0, 0, 0); PG8_SCHED; PG8_LDA(At, 0, 0); PG8_STAGE(PG8_SA(1, 1), a1 + hstep, voffA);
            PG8_WAIT_L(8); PG8_BAR; PG8_WAIT_L(0); PG8_MMA(0, 0, At, B0); PG8_BAR; PG8_SCHED;
            PG8_LDB(B1, 0, 1); PG8_STAGE(PG8_SB(0, 0), b2, voffB);
            PG8_BAR; PG8_WAIT_L(0); PG8_MMA(0, 1, At, B1); PG8_BAR;
            PG8_LDA(At, 0, 1); PG8_STAGE(PG8_SA(0, 0), a2, voffA);
            PG8_BAR; PG8_WAIT_L(0); PG8_MMA(1, 0, At, B0); PG8_BAR; PG8_SCHED;
            PG8_STAGE(PG8_SB(0, 1), b2 + hstep, voffB);
            PG8_WAIT_V(6); PG8_BAR; PG8_MMA(1, 1, At, B1); PG8_BAR;
            PG8_LDB(B0, 1, 0); PG8_SCHED; PG8_LDA(At, 1, 0); PG8_STAGE(PG8_SA(0, 1), a2 + hstep, voffA);
            PG8_WAIT_L(8); PG8_BAR; PG8_WAIT_L(0); PG8_MMA(0, 0, At, B0); PG8_BAR; PG8_SCHED;
            PG8_LDB(B1, 1, 1); PG8_STAGE(PG8_SB(1, 0), b3, voffB);
            PG8_BAR; PG8_WAIT_L(0); PG8_MMA(0, 1, At, B1); PG8_BAR;
            PG8_LDA(At, 1, 1); PG8_STAGE(PG8_SA(1, 0), a3, voffA);
            PG8_BAR; PG8_WAIT_L(0); PG8_MMA(1, 0, At, B0); PG8_BAR; PG8_SCHED;
            PG8_STAGE(PG8_SB(1, 1), b3 + hstep, voffB);
            PG8_WAIT_V(6); PG8_BAR; PG8_MMA(1, 1, At, B1); PG8_BAR;
            }
        }
        if constexpr (ALIGN_EPI) { if (wr == 0) PG8_BAR; }
        if constexpr (!Epi::AFTER_DRAIN) { E(acc, cur, wr, wc, fr, fq); S.done(cur); }
        if (!has_next) break;
#pragma unroll
        for (int a = 0; a < 2; ++a)
#pragma unroll
            for (int b = 0; b < 2; ++b)
#pragma unroll
                for (int m = 0; m < 4; ++m)
#pragma unroll
                    for (int n = 0; n < 2; ++n) acc[a][b][m][n] = (f32x4){0.f, 0.f, 0.f, 0.f};
        cur = nxt; cA = nA; cB = nB; ++ui;
        if constexpr (ALIGN_EPI) { if (wr == 1) PG8_BAR; }
    }
    PG8_WAIT_V(0);
    if constexpr (!ALIGN_EPI) { if (wr == 0) PG8_BAR; }
    PG8_BAR;
    if constexpr (Epi::AFTER_DRAIN) { E.fused(acc, cur, wr, wc, fr, fq, lds, wid, lane); S.done(cur); }
#undef PG8_SA
#undef PG8_SB
#undef PG8_STAGE
#undef PG8_LDA
#undef PG8_LDB
#undef PG8_MMA
#undef PG8_WAIT_V
#undef PG8_WAIT_L
#undef PG8_BAR
#undef PG8_SCHED
}
}


namespace mk {
using pg8::bf16_t; using pg8::bf16x8; using pg8::f32x4; using pg8::u32x4; using pg8::cvt_pk_bf16; using pg8::Unit;
typedef float f32x16 __attribute__((ext_vector_type(16)));
typedef unsigned u32x2 __attribute__((ext_vector_type(2)));
#define LAS __attribute__((address_space(3)))
#define LDS_WAIT() asm volatile("s_waitcnt lgkmcnt(0)" ::: "memory")

constexpr int S = 8192, D = 4096, NG = 128, DFF = 11008, UPW = 22016, PW = 6144;
constexpr int NC = 16, LC = 512;
constexpr float ALPHA = 1.189207115002721f;
constexpr float LN_EPS = 1e-5f;
constexpr float LAMBDA_INIT = 0.2f;
constexpr float LOG2E = 1.4426950408889634f;
constexpr int LDS_BYTES = 147456, LDS_XB = LDS_BYTES - 16;
constexpr size_t CTL_BAR = 4096;

constexpr size_t MiB = 1ull << 20;
constexpr size_t WS_CTL = 0, WS_XB = 1 * MiB, WS_WIN = 65 * MiB, WS_P = 129 * MiB, WS_VT = 225 * MiB, WS_YG = 257 * MiB, WS_MIXA = 289 * MiB,
                 WS_GH = 1 * MiB, WS_AH = 17 * MiB  , WS_WGLU = 353 * MiB, WS_WOUT = 361 * MiB, WS_WUP = 393 * MiB, WS_WDOWN = 565 * MiB,
                 WS_R1 = 651 * MiB, WS_H1B = 779 * MiB, WS_ACT = 843 * MiB, WS_SSMA = 1015 * MiB, WS_SSMAL = WS_SSMA + 65536, WS_SSMBB = WS_SSMAL + 65536,
                 WS_SSME = 1016 * MiB, WS_END = 1017 * MiB;

struct Params { const float* in[27]; float* out; unsigned char* ws; int ph_lo, ph_hi; };

__device__ __forceinline__ float wave_sum(float v) {
#pragma unroll
    for (int o = 1; o < 64; o <<= 1) v += __shfl_xor(v, o);
    return v;
}
__device__ __forceinline__ float bf_lo(unsigned w) { return __uint_as_float(w << 16); }
__device__ __forceinline__ float bf_hi(unsigned w) { return __uint_as_float(w & 0xffff0000u); }
__device__ __forceinline__ float gelu_tanh(float y) {
    const float inner = y * (1.0f + 0.044715f * y * y);
    const float e = __builtin_amdgcn_exp2f(inner * (-2.0f * 0.7978845608028654f * LOG2E));
    return y * __builtin_amdgcn_rcpf(1.0f + e);
}
__device__ __forceinline__ float sigmoidf_(float z) { return __builtin_amdgcn_rcpf(1.0f + __builtin_amdgcn_exp2f(-z * LOG2E)); }

template <int MODE> __device__ __forceinline__ int rowmap(int n) {
    if (MODE == 0) return n;
    const int isg = n >= DFF ? 1 : 0; const int c = isg ? n - DFF : n; return 256 * (c >> 7) + 128 * isg + (c & 127);
}
template <int MODE, bool NTST> __device__ __forceinline__ void transpose_tile(const float* __restrict__ W, int K, int N, bf16_t* __restrict__ WT, LAS float* scr, int item, int lane) {
    const int nblk = N / 64;
    const int kb = item / nblk, nb = item % nblk, k0 = kb * 64, n0 = nb * 64;
#pragma unroll 8
    for (int i = 0; i < 64; ++i) scr[i * 65 + lane] = __builtin_nontemporal_load(W + (size_t)(k0 + i) * N + n0 + lane);
    LDS_WAIT();
    const int c = lane & 7;
#pragma unroll
    for (int j = 0; j < 8; ++j) {
        const int n = (lane >> 3) + 8 * j; const LAS float* s = scr + (8 * c) * 65 + n;
        u32x4 o; o.x = cvt_pk_bf16(s[0], s[65]); o.y = cvt_pk_bf16(s[130], s[195]); o.z = cvt_pk_bf16(s[260], s[325]); o.w = cvt_pk_bf16(s[390], s[455]);
        if (NTST) __builtin_nontemporal_store(o, (u32x4*)(WT + (size_t)rowmap<MODE>(n0 + n) * K + k0 + 8 * c));
        else *(u32x4*)(WT + (size_t)rowmap<MODE>(n0 + n) * K + k0 + 8 * c) = o;
    }
    LDS_WAIT();
}

template <int MODE, bool NTST> __device__ __forceinline__ void transpose_tile_wide(const float* __restrict__ W, int K, int N, bf16_t* __restrict__ WT, LAS float* scr, int item, int lane) {
    const int nblk = N / 64;
    const int kb = item / nblk, nb = item % nblk, k0 = kb * 64, n0 = nb * 64;
    f32x4 v[16];
#pragma unroll
    for (int i = 0; i < 16; ++i) v[i] = __builtin_nontemporal_load((const f32x4*)(W + (size_t)(k0 + 4 * i + (lane >> 4)) * N + n0 + 4 * (lane & 15)));
#pragma unroll
    for (int i = 0; i < 16; ++i) { LAS float* d = scr + (4 * i + (lane >> 4)) * 65 + 4 * (lane & 15); d[0] = v[i][0]; d[1] = v[i][1]; d[2] = v[i][2]; d[3] = v[i][3]; }
    LDS_WAIT();
    const int c = lane & 7;
#pragma unroll
    for (int j = 0; j < 8; ++j) {
        const int n = (lane >> 3) + 8 * j; const LAS float* s = scr + (8 * c) * 65 + n;
        u32x4 o; o.x = cvt_pk_bf16(s[0], s[65]); o.y = cvt_pk_bf16(s[130], s[195]); o.z = cvt_pk_bf16(s[260], s[325]); o.w = cvt_pk_bf16(s[390], s[455]);
        if (NTST) __builtin_nontemporal_store(o, (u32x4*)(WT + (size_t)rowmap<MODE>(n0 + n) * K + k0 + 8 * c));
        else *(u32x4*)(WT + (size_t)rowmap<MODE>(n0 + n) * K + k0 + 8 * c) = o;
    }
    LDS_WAIT();
}

__device__ __forceinline__ void phase0(const Params& p, LAS unsigned char* lds) {
    const int tid = threadIdx.x, lane = tid & 63, wid = tid >> 6;
    const int gw = blockIdx.x * 8 + wid, nw = gridDim.x * 8;
    const int gt = blockIdx.x * 512 + tid, ngt = gridDim.x * 512;
    unsigned char* ws = p.ws;
    {
        const f32x4* x4 = (const f32x4*)p.in[0]; u32x4* xb = (u32x4*)(ws + WS_XB);
        const int n8 = S * D / 8;
        for (int i = gt; i < n8; i += ngt) {
            const f32x4 a = __builtin_nontemporal_load(x4 + 2 * i), b = __builtin_nontemporal_load(x4 + 2 * i + 1);
            u32x4 w; w.x = cvt_pk_bf16(a[0], a[1]); w.y = cvt_pk_bf16(a[2], a[3]); w.z = cvt_pk_bf16(b[0], b[1]); w.w = cvt_pk_bf16(b[2], b[3]);
            xb[i] = w;
        }
    }
    for (int i = gt; i < NG * 64; i += ngt) {
        const int g = i >> 6, n = i & 63;
        const double step = exp((double)p.in[2][g]);
        const double lr = (double)p.in[3][i], li = (double)p.in[4][i];
        const double mag = exp(lr * step); double sn, cs; sincos(li * step, &sn, &cs);
        const double are = mag * cs, aim = mag * sn;
        const double den = lr * lr + li * li, nr = are - 1.0, ni = aim;
        const double zre = (nr * lr + ni * li) / den, zim = (ni * lr - nr * li) / den;
        float* A = (float*)(ws + WS_SSMA); float* AL = (float*)(ws + WS_SSMAL); bf16_t* BB = (bf16_t*)(ws + WS_SSMBB);
        const float are_f = (float)are, aim_f = (float)aim;
        A[2 * i] = are_f; A[2 * i + 1] = aim_f;
        double pr = (double)are_f, pi = (double)aim_f;
#pragma unroll
        for (int s = 0; s < 9; ++s) { const double t = pr * pr - pi * pi; pi = 2.0 * pr * pi; pr = t; }
        AL[2 * i] = (float)pr; AL[2 * i + 1] = (float)pi;
        const float* bre = p.in[5] + (size_t)i * 16; const float* bim = p.in[6] + (size_t)i * 16;
        unsigned wre[8], wim[8];
#pragma unroll
        for (int h = 0; h < 16; h += 2) {
            const double br0 = bre[h], bi0 = bim[h], br1 = bre[h + 1], bi1 = bim[h + 1];
            wre[h >> 1] = cvt_pk_bf16((float)(zre * br0 - zim * bi0), (float)(zre * br1 - zim * bi1));
            wim[h >> 1] = cvt_pk_bf16((float)(zre * bi0 + zim * br0), (float)(zre * bi1 + zim * br1));
        }
        u32x4* dre = (u32x4*)(BB + ((size_t)g * 128 + n) * 16); u32x4* dim = (u32x4*)(BB + ((size_t)g * 128 + 64 + n) * 16);
        dre[0] = (u32x4){wre[0], wre[1], wre[2], wre[3]}; dre[1] = (u32x4){wre[4], wre[5], wre[6], wre[7]};
        dim[0] = (u32x4){wim[0], wim[1], wim[2], wim[3]}; dim[1] = (u32x4){wim[4], wim[5], wim[6], wim[7]};
    }
    if (blockIdx.x == 0) { unsigned* bw = (unsigned*)(ws + WS_CTL + CTL_BAR); for (int i = tid; i < 3456; i += 512) bw[i] = 0u; }
    if (blockIdx.x == 0 && wid == 0) {
        float s1 = p.in[12][lane] * p.in[13][lane] + p.in[12][lane + 64] * p.in[13][lane + 64];
        float s2 = p.in[14][lane] * p.in[15][lane] + p.in[14][lane + 64] * p.in[15][lane + 64];
        s1 = wave_sum(s1); s2 = wave_sum(s2);
        if (lane == 0) ((float*)(ws + WS_CTL))[0] = expf(s1) - expf(s2) + LAMBDA_INIT;
    }
    LAS float* scr = (LAS float*)(lds + wid * (64 * 65 * 4));
    constexpr int T_IN = (D / 64) * (8192 / 64), T_GLU = 32 * 32, T_OUT = 64 * 64, T_UP = (D / 64) * (UPW / 64), T_DN = (DFF / 64) * (D / 64);
    constexpr int E_IN = T_IN, E_GLU = E_IN + T_GLU, E_OUT = E_GLU + T_OUT, E_UP = E_OUT + T_UP, E_DN = E_UP + T_DN;
    for (int it = gw; it < E_UP; it += nw) {
        if (it < E_IN) transpose_tile_wide<0, false>(p.in[1], D, 8192, (bf16_t*)(ws + WS_WIN), scr, it, lane);
        else if (it < E_GLU) transpose_tile_wide<0, true>(p.in[10], 2048, 2048, (bf16_t*)(ws + WS_WGLU), scr, it - E_IN, lane);
        else if (it < E_OUT) transpose_tile_wide<0, true>(p.in[18], D, D, (bf16_t*)(ws + WS_WOUT), scr, it - E_GLU, lane);
        else transpose_tile_wide<1, true>(p.in[21], D, UPW, (bf16_t*)(ws + WS_WUP), scr, it - E_OUT, lane);
    }
}

template <bool SWAP16> struct EpiBf16PlainT {
    static constexpr bool PERM = true, AFTER_DRAIN = false;
    bf16_t* O; int ldc;
    __device__ __forceinline__ void operator()(const f32x4 (&acc)[2][2][4][2], const Unit& u, int wr, int wc, int fr, int fq) const {
        const int row0 = u.pm * 256 + wr * 64 + fr, col0 = u.pn * 256 + wc * 32 + 8 * fq;
#pragma unroll
        for (int ai = 0; ai < 2; ++ai)
#pragma unroll
            for (int m = 0; m < 4; ++m) { bf16_t* rowp = O + (size_t)(row0 + ai * 128 + m * 16) * ldc + col0;
#pragma unroll
                for (int bj = 0; bj < 2; ++bj) { const f32x4 v0 = acc[ai][bj][m][0], v1 = acc[ai][bj][m][1];
                    u32x4 w; w.x = cvt_pk_bf16(v0[0], v0[1]); w.y = cvt_pk_bf16(v0[2], v0[3]); w.z = cvt_pk_bf16(v1[0], v1[1]); w.w = cvt_pk_bf16(v1[2], v1[3]);
                    if (SWAP16 && (m & 1)) w = (u32x4){w.z, w.w, w.x, w.y};
                    *(u32x4*)(rowp + bj * 128) = w; } }
    }
};
typedef EpiBf16PlainT<false> EpiBf16Plain;
struct EpiGlu {
    static constexpr bool PERM = true, AFTER_DRAIN = false;
    bf16_t* O; int ldo; const bf16_t* YG; const float* bias;
    __device__ __forceinline__ void operator()(const f32x4 (&acc)[2][2][4][2], const Unit& u, int wr, int wc, int fr, int fq) const {
        const int row0 = u.pm * 256 + wr * 64 + fr, col0 = u.pn * 256 + wc * 32 + 8 * fq;
#pragma unroll
        for (int bj = 0; bj < 2; ++bj) {
            const f32x4 b0 = *(const f32x4*)(bias + col0 + bj * 128), b1 = *(const f32x4*)(bias + col0 + bj * 128 + 4);
#pragma unroll
            for (int ai = 0; ai < 2; ++ai)
#pragma unroll
                for (int m = 0; m < 4; ++m) { const size_t row = (size_t)(row0 + ai * 128 + m * 16);
                    const u32x4 y = *(const u32x4*)(YG + row * 2048 + col0 + bj * 128);
                    const f32x4 z0 = acc[ai][bj][m][0] + b0, z1 = acc[ai][bj][m][1] + b1;
                    u32x4 w;
                    w.x = cvt_pk_bf16(bf_lo(y.x) * sigmoidf_(z0[0]), bf_hi(y.x) * sigmoidf_(z0[1]));
                    w.y = cvt_pk_bf16(bf_lo(y.y) * sigmoidf_(z0[2]), bf_hi(y.y) * sigmoidf_(z0[3]));
                    w.z = cvt_pk_bf16(bf_lo(y.z) * sigmoidf_(z1[0]), bf_hi(y.z) * sigmoidf_(z1[1]));
                    w.w = cvt_pk_bf16(bf_lo(y.w) * sigmoidf_(z1[2]), bf_hi(y.w) * sigmoidf_(z1[3]));
                    *(u32x4*)(O + row * ldo + col0 + bj * 128) = w; } }
    }
};
struct EpiResX {
    static constexpr bool PERM = false, AFTER_DRAIN = false;
    bf16_t* CB; const bf16_t* baseB; int ld;
    __device__ __forceinline__ void operator()(const f32x4 (&acc)[2][2][4][2], const Unit& u, int wr, int wc, int fr, int fq) const {
        const int row0 = u.pm * 256 + wr * 64 + fr, col0 = u.pn * 256 + wc * 32 + 4 * fq;
#pragma unroll
        for (int ai = 0; ai < 2; ++ai)
#pragma unroll
            for (int m = 0; m < 4; ++m) { const size_t off = (size_t)(row0 + ai * 128 + m * 16) * ld + col0;
#pragma unroll
                for (int bj = 0; bj < 2; ++bj)
#pragma unroll
                    for (int n = 0; n < 2; ++n) { const u32x2 hb = *(const u32x2*)(baseB + off + bj * 128 + n * 16);
                        const f32x4 b = {bf_lo(hb.x), bf_hi(hb.x), bf_lo(hb.y), bf_hi(hb.y)};
                        const f32x4 r = b * ALPHA + acc[ai][bj][m][n];
                        u32x2 w; w.x = cvt_pk_bf16(r[0], r[1]); w.y = cvt_pk_bf16(r[2], r[3]); *(u32x2*)(CB + off + bj * 128 + n * 16) = w; } }
    }
};
struct EpiResB {
    static constexpr bool PERM = false, AFTER_DRAIN = false;
    bf16_t* CB; const bf16_t* baseB; int ld;
    __device__ __forceinline__ void operator()(const f32x4 (&acc)[2][2][4][2], const Unit& u, int wr, int wc, int fr, int fq) const {
        const int row0 = u.pm * 256 + wr * 64 + fr, col0 = u.pn * 256 + wc * 32 + 4 * fq;
#pragma unroll
        for (int ai = 0; ai < 2; ++ai)
#pragma unroll
            for (int m = 0; m < 4; ++m) { const size_t off = (size_t)(row0 + ai * 128 + m * 16) * ld + col0;
#pragma unroll
                for (int bj = 0; bj < 2; ++bj)
#pragma unroll
                    for (int n = 0; n < 2; ++n) { const u32x2 hb = *(const u32x2*)(baseB + off + bj * 128 + n * 16);
                        const f32x4 b = {bf_lo(hb.x), bf_hi(hb.x), bf_lo(hb.y), bf_hi(hb.y)};
                        const f32x4 r = b * ALPHA + acc[ai][bj][m][n];
                        u32x2 w; w.x = cvt_pk_bf16(r[0], r[1]); w.y = cvt_pk_bf16(r[2], r[3]); *(u32x2*)(CB + off + bj * 128 + n * 16) = w; } }
    }
};
struct EpiConvGate {
    static constexpr bool PERM = true, AFTER_DRAIN = false;
    bf16_t* ACT; bf16_t* GH; bf16_t* AH; const float* cw; const float* cb;
    __device__ __forceinline__ void operator()(f32x4 (&acc)[2][2][4][2], const Unit& u, int wr, int wc, int fr, int fq) const {
        const int ch0 = u.pn * 128 + wc * 32 + 8 * fq;
#pragma unroll
        for (int ai = 0; ai < 2; ++ai) {
            const int strip = 4 * u.pm + 2 * ai + wr;
            if (fr >= 14) { const f32x4 v0 = acc[ai][1][3][0], v1 = acc[ai][1][3][1];
                u32x4 w; w.x = cvt_pk_bf16(v0[0], v0[1]); w.y = cvt_pk_bf16(v0[2], v0[3]); w.z = cvt_pk_bf16(v1[0], v1[1]); w.w = cvt_pk_bf16(v1[2], v1[3]);
                *(u32x4*)(GH + (size_t)(strip * 4 + (fr - 14)) * DFF + ch0) = w; }
            if (fr < 2) { const f32x4 v0 = acc[ai][1][0][0], v1 = acc[ai][1][0][1], a0 = acc[ai][0][0][0], a1 = acc[ai][0][0][1];
                u32x4 w; w.x = cvt_pk_bf16(v0[0], v0[1]); w.y = cvt_pk_bf16(v0[2], v0[3]); w.z = cvt_pk_bf16(v1[0], v1[1]); w.w = cvt_pk_bf16(v1[2], v1[3]);
                *(u32x4*)(GH + (size_t)(strip * 4 + 2 + fr) * DFF + ch0) = w;
                w.x = cvt_pk_bf16(a0[0], a0[1]); w.y = cvt_pk_bf16(a0[2], a0[3]); w.z = cvt_pk_bf16(a1[0], a1[1]); w.w = cvt_pk_bf16(a1[2], a1[3]);
                *(u32x4*)(AH + (size_t)(strip * 2 + fr) * DFF + ch0) = w; }
        }
#define DPPF(x, ctrl) __builtin_bit_cast(float, __builtin_amdgcn_update_dpp(0, __builtin_bit_cast(int, (x)), (ctrl), 0xf, 0xf, true))
#pragma unroll
        for (int n = 0; n < 2; ++n) {
            const f32x4 w0v = *(const f32x4*)(cw + ch0 + 4 * n), w1v = *(const f32x4*)(cw + DFF + ch0 + 4 * n), w2v = *(const f32x4*)(cw + 2 * DFF + ch0 + 4 * n), bv = *(const f32x4*)(cb + ch0 + 4 * n);
#pragma unroll
            for (int e = 0; e < 4; ++e) {
                const float w0 = w0v[e], w1 = w1v[e], w2 = w2v[e], bb = bv[e];
#pragma unroll
                for (int ai = 0; ai < 2; ++ai) {
#pragma unroll
                    for (int m = 0; m < 4; ++m) {
                        const float g = acc[ai][1][m][n][e];
                        float g1 = DPPF(g, 0x111), g2 = DPPF(g, 0x112);
                        if (m > 0) { const float gp = acc[ai][1][m - 1][n][e]; g1 += DPPF(gp, 0x10F); g2 += DPPF(gp, 0x10E); }
                        const float gc = bb + w0 * g2 + w1 * g1 + w2 * g;
                        acc[ai][0][m][n][e] = gc * sigmoidf_(gc) * acc[ai][0][m][n][e];
                    }
                }
            }
        }
#undef DPPF
        const int row0 = u.pm * 256 + wr * 64 + fr;
#pragma unroll
        for (int ai = 0; ai < 2; ++ai)
#pragma unroll
            for (int m = 0; m < 4; ++m) { const f32x4 v0 = acc[ai][0][m][0], v1 = acc[ai][0][m][1];
                u32x4 w; w.x = cvt_pk_bf16(v0[0], v0[1]); w.y = cvt_pk_bf16(v0[2], v0[3]); w.z = cvt_pk_bf16(v1[0], v1[1]); w.w = cvt_pk_bf16(v1[2], v1[3]);
                *(u32x4*)(ACT + (size_t)(row0 + ai * 128 + m * 16) * DFF + ch0) = w; }
    }
};

template <bool OUTF> __device__ __forceinline__ void ln_rows(bf16_t* RB, float* OF, const float* gam, const float* bet) {
    const int lane = threadIdx.x & 63, gw = blockIdx.x * 8 + (threadIdx.x >> 6), nw = gridDim.x * 8;
    for (int row = gw; row < S; row += nw) {
        u32x2* r2 = (u32x2*)(RB + (size_t)row * D) + lane;
        f32x4 v[16]; float s = 0.f;
#pragma unroll
        for (int j = 0; j < 16; ++j) { const u32x2 w = r2[64 * j]; v[j] = (f32x4){bf_lo(w.x), bf_hi(w.x), bf_lo(w.y), bf_hi(w.y)}; s += (v[j][0] + v[j][1]) + (v[j][2] + v[j][3]); }
        const float mean = wave_sum(s) * (1.0f / D); float q = 0.f;
#pragma unroll
        for (int j = 0; j < 16; ++j) { v[j] = v[j] - mean; q += (v[j][0] * v[j][0] + v[j][1] * v[j][1]) + (v[j][2] * v[j][2] + v[j][3] * v[j][3]); }
        const float rstd = 1.0f / sqrtf(wave_sum(q) * (1.0f / D) + LN_EPS);
#pragma unroll
        for (int j = 0; j < 16; ++j) {
            const f32x4 g = ((const f32x4*)gam)[64 * j + lane], b = ((const f32x4*)bet)[64 * j + lane];
            const f32x4 o = v[j] * rstd * g + b;
            if (OUTF) __builtin_nontemporal_store(o, (f32x4*)(OF + (size_t)row * D) + 64 * j + lane);
            else { u32x2 w; w.x = cvt_pk_bf16(o[0], o[1]); w.y = cvt_pk_bf16(o[2], o[3]); r2[64 * j] = w; }
        }
    }
}

template <int PASS> __device__ __forceinline__ void ssm_pass(const Params& p, LAS unsigned char* lds) {
    const int tid = threadIdx.x, lane = tid & 63, wid = tid >> 6, l15 = lane & 15, q4 = lane >> 4;
    const int gw = blockIdx.x * 8 + wid, nw = gridDim.x * 8;
    unsigned char* ws = p.ws;
    const bf16_t* P = (const bf16_t*)(ws + WS_P);
    const float* A = (const float*)(ws + WS_SSMA); const float* AL = (const float*)(ws + WS_SSMAL); const bf16_t* BB = (const bf16_t*)(ws + WS_SSMBB);
    float* E = (float*)(ws + WS_SSME); bf16_t* YG = (bf16_t*)(ws + WS_YG);
    LAS unsigned char* bu = lds + wid * (16 * 528);
    for (int item = gw; item < NG * NC; item += nw) {
        const int g = item / NC, c = item % NC;
        const float are = A[2 * (g * 64 + lane)], aim = A[2 * (g * 64 + lane) + 1];
        bf16x8 bbf[8];
#pragma unroll
        for (int blk = 0; blk < 8; ++blk) {
            bbf[blk] = (bf16x8){0, 0, 0, 0, 0, 0, 0, 0};
            if (q4 < 2) bbf[blk] = *(const bf16x8*)(BB + ((size_t)g * 128 + 16 * blk + l15) * 16 + 8 * q4);
        }
        bf16x8 cf[4]; f32x4 dsk = {0.f, 0.f, 0.f, 0.f};
        if (PASS == 2) {
#pragma unroll
            for (int ks = 0; ks < 4; ++ks) {
                const float* src = (ks < 2 ? p.in[7] : p.in[8]) + ((size_t)g * 16 + l15) * 64 + 32 * (ks & 1) + 8 * q4;
                const f32x4 a = *(const f32x4*)src, b = *(const f32x4*)(src + 4); const float sg = ks < 2 ? 1.0f : -1.0f;
                u32x4 w; w.x = cvt_pk_bf16(sg * a[0], sg * a[1]); w.y = cvt_pk_bf16(sg * a[2], sg * a[3]); w.z = cvt_pk_bf16(sg * b[0], sg * b[1]); w.w = cvt_pk_bf16(sg * b[2], sg * b[3]);
                cf[ks] = *(bf16x8*)&w;
            }
            dsk = *(const f32x4*)(p.in[9] + g * 16 + 4 * q4);
        }
        float hre = 0.f, him = 0.f;
        if (PASS == 2) {
            const float alr = AL[2 * (g * 64 + lane)], ali = AL[2 * (g * 64 + lane) + 1];
            for (int cc = 0; cc < c; ++cc) {
                const float er = E[((size_t)g * NC + cc) * 128 + lane], ei = E[((size_t)g * NC + cc) * 128 + 64 + lane];
                const float nr = alr * hre - ali * him + er, ni = alr * him + ali * hre + ei; hre = nr; him = ni;
            }
        }
        const int t0 = c * LC;
        for (int tile = 0; tile < LC / 16; ++tile) {
            const int tb = t0 + 16 * tile;
            bf16x8 uf = (bf16x8){0, 0, 0, 0, 0, 0, 0, 0};
            if (q4 < 2) uf = *(const bf16x8*)(P + (size_t)(tb + l15) * PW + g * 16 + 8 * q4);
#pragma unroll
            for (int blk = 0; blk < 8; ++blk) {
                f32x4 acc = {0.f, 0.f, 0.f, 0.f};
                acc = __builtin_amdgcn_mfma_f32_16x16x32_bf16(bbf[blk], uf, acc, 0, 0, 0);
                *(LAS f32x4*)(bu + l15 * 528 + (16 * blk + 4 * q4) * 4) = acc;
            }
            LDS_WAIT();
#pragma unroll
            for (int t = 0; t < 16; ++t) {
                const float br = *(const LAS float*)(bu + t * 528 + lane * 4), bi = *(const LAS float*)(bu + t * 528 + 256 + lane * 4);
                const float nr = are * hre - aim * him + br, ni = are * him + aim * hre + bi; hre = nr; him = ni;
                if (PASS == 2) {
                    const unsigned w = cvt_pk_bf16(hre, him);
                    *(LAS unsigned short*)(bu + t * 528 + lane * 2) = (unsigned short)(w & 0xffffu);
                    *(LAS unsigned short*)(bu + t * 528 + 128 + lane * 2) = (unsigned short)(w >> 16);
                }
            }
            if (PASS == 2) {
                LDS_WAIT();
                f32x4 y = {0.f, 0.f, 0.f, 0.f};
#pragma unroll
                for (int ks = 0; ks < 4; ++ks) {
                    const bf16x8 hb = *(const LAS bf16x8*)(bu + l15 * 528 + ks * 64 + q4 * 16);
                    y = __builtin_amdgcn_mfma_f32_16x16x32_bf16(cf[ks], hb, y, 0, 0, 0);
                }
                const u32x2 uu = *(const u32x2*)(P + (size_t)(tb + l15) * PW + g * 16 + 4 * q4);
                const float y0 = gelu_tanh(y[0] + dsk[0] * bf_lo(uu.x)), y1 = gelu_tanh(y[1] + dsk[1] * bf_hi(uu.x));
                const float y2 = gelu_tanh(y[2] + dsk[2] * bf_lo(uu.y)), y3 = gelu_tanh(y[3] + dsk[3] * bf_hi(uu.y));
                u32x2 w; w.x = cvt_pk_bf16(y0, y1); w.y = cvt_pk_bf16(y2, y3);
                *(u32x2*)(YG + (size_t)(tb + l15) * 2048 + g * 16 + 4 * q4) = w;
                LDS_WAIT();
            }
        }
        if (PASS == 1) { E[((size_t)g * NC + c) * 128 + lane] = hre; E[((size_t)g * NC + c) * 128 + 64 + lane] = him; }
    }
}

constexpr int AT_KB = 64 * 512, AT_VB = 256 * 128, AT_STAGE = AT_KB + AT_VB, AT_TBL = 2 * AT_STAGE, AT_XROW = 1040;
__device__ __forceinline__ int t5_bucket(int rel) {
    const int n = rel < 0 ? -rel : rel; int b;
    if (n < 8) b = n; else if (n < 12) b = 8; else if (n < 16) b = 9; else if (n < 23) b = 10; else if (n < 32) b = 11; else if (n < 46) b = 12; else if (n < 64) b = 13; else if (n < 91) b = 14; else b = 15;
    return b + (rel > 0 ? 16 : 0);
}
__device__ __forceinline__ void attn_item(const Params& p, LAS unsigned char* lds, int head, int j) {
    int tid_ = threadIdx.x; asm volatile("" : "+v"(tid_));
    const int tid = tid_, lane = tid & 63, wid = __builtin_amdgcn_readfirstlane(tid >> 6), l31 = lane & 31, half = lane >> 5;
    const int rg = wid >> 1, c = wid & 1;
    unsigned char* ws = p.ws;
    const bf16_t* P = (const bf16_t*)(ws + WS_P); const bf16_t* VT = (const bf16_t*)(ws + WS_VT); bf16_t* MIXA = (bf16_t*)(ws + WS_MIXA);
    const float lam = ((const float*)(ws + WS_CTL))[0];
    const int q0 = 128 * j, nkt = 2 * j + 2;
    LAS float* tbl = (LAS float*)(lds + AT_TBL);
    if (tid < 320) tbl[tid] = p.in[17][t5_bucket(tid - 256) * 8 + head] * LOG2E;
    const float bfar = p.in[17][15 * 8 + head] * LOG2E;
    const float CS = 0.08838834764831845f * LOG2E;
    const unsigned qoff0 = (unsigned)(((32 * rg + l31) * PW + c * 128 + 8 * half) * 2);
    const char* qbase = (const char*)(P + (size_t)q0 * PW + 2048 + head * 256);
    bf16x8 qf[8];
#pragma unroll
    for (int ks = 0; ks < 8; ++ks) qf[ks] = *(const bf16x8*)(qbase + qoff0 + 32 * ks);
    const char* kgb = (const char*)(P + 4096 + head * 256); const char* vgb = (const char*)(VT + (size_t)head * 256 * S);
#define AT_DMA(kt, buf) do { int ln = lane; asm volatile("" : "+v"(ln)); _Pragma("unroll") for (int i = 0; i < 4; ++i) { \
        const int n_ = 4 * wid + i, kr_ = 2 * n_ + (ln >> 5), kc_ = (ln & 31) ^ (kr_ & 15), vr_ = 8 * n_ + (ln >> 3), vc_ = (ln & 7) ^ ((vr_ >> 1) & 7); \
        const unsigned ko_ = (unsigned)(kr_ * PW + kc_ * 8) * 2u, vo_ = (unsigned)(vr_ * S + vc_ * 8) * 2u; \
        __builtin_amdgcn_global_load_lds((const unsigned*)(kgb + (size_t)(kt) * 64 * PW * 2 + ko_), (LAS unsigned*)(lds + (buf) * AT_STAGE + (4 * wid + i) * 1024), 16, 0, 0); \
        __builtin_amdgcn_global_load_lds((const unsigned*)(vgb + (size_t)(kt) * 128 + vo_), (LAS unsigned*)(lds + (buf) * AT_STAGE + AT_KB + (4 * wid + i) * 1024), 16, 0, 0); } } while (0)
#define AT_VMWAIT() asm volatile("s_waitcnt vmcnt(0)" ::: "memory")
    const int kbase0 = l31 * 512 + c * 256 + (((l31 & 14) | (half ^ (l31 & 1))) << 4);
    const int vbase0 = l31 * 128 + ((half ^ (l31 >> 4)) & 1) * 8 + (((l31 >> 1) & 7) << 4);
    const int xoff0 = (32 * rg + l31) * AT_XROW;
    f32x16 o[8];
#pragma unroll
    for (int db = 0; db < 8; ++db)
#pragma unroll
        for (int r = 0; r < 16; ++r) o[db][r] = 0.f;
    float m_ref = -__builtin_inff(), lsum = 0.f;
#define AT_BAR() do { asm volatile("" ::: "memory"); __builtin_amdgcn_s_barrier(); asm volatile("" ::: "memory"); } while (0)
#define AT_QK(hb) do { bf16x8 kf[8]; \
        _Pragma("unroll") for (int ks = 0; ks < 8; ++ks) kf[ks] = *(const LAS bf16x8*)(Kb + (kbase ^ (ks * 32)) + (hb) * 32 * 512); \
        _Pragma("unroll") for (int r = 0; r < 16; ++r) s[r] = 0.f; \
        _Pragma("unroll") for (int ks = 0; ks < 8; ++ks) s = __builtin_amdgcn_mfma_f32_32x32x16_bf16(kf[ks], qf[ks], s, 0, 0, 0); } while (0)
#define AT_SM(hb) do { \
        const bool near_ = kt >= nkt - 4; float mx; \
        if (near_) { const LAS float* tb = tbl + (kt * 64 + 32 * (hb) + 4 * half - (q0 + 32 * rg + l31) + 256); \
            _Pragma("unroll") for (int r = 0; r < 16; ++r) s[r] = s[r] * CS + tb[(r & 3) + 8 * (r >> 2)]; \
            mx = s[0]; \
            _Pragma("unroll") for (int r = 1; r < 16; ++r) mx = fmaxf(mx, s[r]); \
        } else { mx = s[0]; \
            _Pragma("unroll") for (int r = 1; r < 16; ++r) mx = fmaxf(mx, s[r]); \
            mx = mx * CS + bfar; }                                            \
        mx = fmaxf(mx, __shfl_xor(mx, 32)); \
        if (__any(mx > m_ref + 8.0f)) { \
            const float mn = fmaxf(m_ref, mx); const float al = __builtin_amdgcn_exp2f(m_ref - mn); m_ref = mn; lsum *= al; \
            _Pragma("unroll") for (int db = 0; db < 8; ++db) _Pragma("unroll") for (int r = 0; r < 16; ++r) o[db][r] *= al; } \
        float ps = 0.f; \
        if (near_) { _Pragma("unroll") for (int r = 0; r < 16; ++r) { s[r] = __builtin_amdgcn_exp2f(s[r] - m_ref); ps += s[r]; } } \
        else { const float bm_ = bfar - m_ref; _Pragma("unroll") for (int r = 0; r < 16; ++r) { s[r] = __builtin_amdgcn_exp2f(s[r] * CS + bm_); ps += s[r]; } } \
        lsum += ps; \
        { u32x4 w; \
          w.x = cvt_pk_bf16(s[0], s[1]); w.y = cvt_pk_bf16(s[2], s[3]); w.z = cvt_pk_bf16(s[4], s[5]); w.w = cvt_pk_bf16(s[6], s[7]); pf[0] = *(bf16x8*)&w; \
          w.x = cvt_pk_bf16(s[8], s[9]); w.y = cvt_pk_bf16(s[10], s[11]); w.z = cvt_pk_bf16(s[12], s[13]); w.w = cvt_pk_bf16(s[14], s[15]); pf[1] = *(bf16x8*)&w; } } while (0)
#define AT_VLOAD(hb, db_) do { int vb_ = vbase0 + (db_) * 4096; asm volatile("" : "+v"(vb_)); _Pragma("unroll") for (int s2 = 0; s2 < 2; ++s2) { \
        const u32x2 lo_ = *(const LAS u32x2*)(Vb + (vb_ ^ ((2 * (hb) + s2) * 32))), hi_ = *(const LAS u32x2*)(Vb + (vb_ ^ ((2 * (hb) + s2) * 32 + 16))); \
        vf[(db_) & 1][s2] = (u32x4){lo_.x, lo_.y, hi_.x, hi_.y}; } } while (0)
#define AT_PV(hb) do { u32x4 vf[2][2]; AT_VLOAD(hb, 0); \
        _Pragma("unroll") for (int db = 0; db < 8; ++db) { \
            if (db + 1 < 8) AT_VLOAD(hb, db + 1); \
            o[db] = __builtin_amdgcn_mfma_f32_32x32x16_bf16(*(bf16x8*)&vf[db & 1][0], pf[0], o[db], 0, 0, 0); \
            o[db] = __builtin_amdgcn_mfma_f32_32x32x16_bf16(*(bf16x8*)&vf[db & 1][1], pf[1], o[db], 0, 0, 0); } } while (0)
    AT_DMA(0, 0); AT_VMWAIT();
    __syncthreads();
    if (wid >= 4) AT_BAR();
    f32x16 s; bf16x8 pf[2];
#pragma unroll
    for (int r = 0; r < 16; ++r) s[r] = 0.f;
    pf[0] = (bf16x8){0, 0, 0, 0, 0, 0, 0, 0}; pf[1] = pf[0];
    for (int kt = 0; kt < nkt; ++kt) {
        const int cur = kt & 1;
        const bool more = kt + 1 < nkt;
        const bool active = !(kt == 2 * j + 1 && rg < 2);
        const LAS unsigned char* Kb = lds + cur * AT_STAGE; const LAS unsigned char* Vb = Kb + AT_KB;
        int kbase = kbase0; asm volatile("" : "+v"(kbase));
        if (active) { AT_QK(0); AT_SM(0); }
        AT_BAR();
        if (more) AT_DMA(kt + 1, cur ^ 1);
        if (active) { AT_PV(0); AT_QK(1); }
        AT_BAR();
        if (active) { AT_SM(1); }
        AT_VMWAIT();
        AT_BAR();
        if (active) { AT_PV(1); }
        AT_BAR();
    }
    if (wid < 4) AT_BAR();
#undef AT_BAR
#undef AT_QK
#undef AT_SM
#undef AT_VLOAD
#undef AT_PV
#undef AT_DMA
    const float ltot = lsum + __shfl_xor(lsum, 32);
    const float inv = 1.0f / ltot;
    int xo = xoff0 + 16 * half; asm volatile("" : "+v"(xo));
    if (c == 1) {
        LAS unsigned char* xrow = lds + xo;
        const float f = lam * inv;
#pragma unroll
        for (int db = 0; db < 8; ++db)
#pragma unroll
            for (int r4 = 0; r4 < 4; ++r4) {
                f32x4 v = {o[db][4 * r4] * f, o[db][4 * r4 + 1] * f, o[db][4 * r4 + 2] * f, o[db][4 * r4 + 3] * f};
                *(LAS f32x4*)(xrow + (32 * db + 8 * r4) * 4) = v;
            }
    }
    __syncthreads();
    if (c == 0) {
        asm volatile("" : "+v"(xo));
        LAS unsigned char* xrow = lds + xo;
        float ss = 0.f;
#pragma unroll
        for (int db = 0; db < 8; ++db)
#pragma unroll
            for (int r4 = 0; r4 < 4; ++r4) {
                const f32x4 x1 = *(const LAS f32x4*)(xrow + (32 * db + 8 * r4) * 4);
#pragma unroll
                for (int e = 0; e < 4; ++e) { const float x = o[db][4 * r4 + e] * inv - x1[e]; o[db][4 * r4 + e] = x; ss += x * x; }
                if ((r4 & 1) == 1) __builtin_amdgcn_sched_barrier(0);
            }
        ss += __shfl_xor(ss, 32);
        const float rms = (1.0f - LAMBDA_INIT) / sqrtf(ss * (1.0f / 256.0f) + LN_EPS);
        LDS_WAIT();
        int xb = xoff0 + 8 * half; asm volatile("" : "+v"(xb));
        LAS unsigned char* brow = lds + xb;
        int go = 16 * half; asm volatile("" : "+v"(go));
        const char* gp = (const char*)p.in[16] + go;
#pragma unroll
        for (int db = 0; db < 8; ++db)
#pragma unroll
            for (int r4 = 0; r4 < 4; ++r4) {
                const f32x4 g = *(const f32x4*)(gp + (32 * db + 8 * r4) * 4);
                u32x2 w; w.x = cvt_pk_bf16(o[db][4 * r4] * rms * g[0], o[db][4 * r4 + 1] * rms * g[1]); w.y = cvt_pk_bf16(o[db][4 * r4 + 2] * rms * g[2], o[db][4 * r4 + 3] * rms * g[3]);
                *(LAS u32x2*)(brow + (32 * db + 8 * r4) * 2) = w;
                if ((r4 & 1) == 1) __builtin_amdgcn_sched_barrier(0);
            }
    }
    __syncthreads();
    {
        int co = (tid >> 5) * AT_XROW + (tid & 31) * 16; asm volatile("" : "+v"(co));
        unsigned mo = (unsigned)(((tid >> 5) * D + (tid & 31) * 8) * 2); asm volatile("" : "+v"(mo));
        char* mb = (char*)(MIXA + (size_t)q0 * D + 2048 + head * 256);
#pragma unroll
        for (int i = 0; i < 8; ++i) {
            const u32x4 w = *(const LAS u32x4*)(lds + co + i * 16 * AT_XROW);
            *(u32x4*)(mb + mo + (size_t)i * 16 * D * 2) = w;
        }
    }
    __syncthreads();
}
__device__ __forceinline__ void attn_phase(const Params& p, LAS unsigned char* lds) {
    for (int pr = blockIdx.x; pr < 256; pr += gridDim.x) {
        const int head = pr & 7, i = pr >> 3;
        attn_item(p, lds, head, 63 - i);
        attn_item(p, lds, head, i);
    }
}

__device__ __forceinline__ void unpack8(const u32x4 v, float (&f)[8]) { f[0] = bf_lo(v.x); f[1] = bf_hi(v.x); f[2] = bf_lo(v.y); f[3] = bf_hi(v.y); f[4] = bf_lo(v.z); f[5] = bf_hi(v.z); f[6] = bf_lo(v.w); f[7] = bf_hi(v.w); }
__device__ __forceinline__ void conv_fix(const Params& p) {
    const bf16_t* GH = (const bf16_t*)(p.ws + WS_GH); const bf16_t* AH = (const bf16_t*)(p.ws + WS_AH); bf16_t* ACT = (bf16_t*)(p.ws + WS_ACT);
    const float* cw = p.in[22]; const float* cb = p.in[23];
    const int gt = blockIdx.x * 512 + threadIdx.x, ngt = gridDim.x * 512;
    constexpr int NV = DFF / 8, NSTRIP = S / 64;
    for (int it = gt; it < NV * NSTRIP; it += ngt) {
        const int cv = it % NV, st = it / NV, ch = cv * 8;
        float gm2[8], gm1[8], g0[8], g1[8], a0[8], a1[8];
#pragma unroll
        for (int e = 0; e < 8; ++e) { gm2[e] = 0.f; gm1[e] = 0.f; }
        if (st > 0) { unpack8(*(const u32x4*)(GH + (size_t)((st - 1) * 4 + 0) * DFF + ch), gm2); unpack8(*(const u32x4*)(GH + (size_t)((st - 1) * 4 + 1) * DFF + ch), gm1); }
        unpack8(*(const u32x4*)(GH + (size_t)(st * 4 + 2) * DFF + ch), g0); unpack8(*(const u32x4*)(GH + (size_t)(st * 4 + 3) * DFF + ch), g1);
        unpack8(*(const u32x4*)(AH + (size_t)(st * 2 + 0) * DFF + ch), a0); unpack8(*(const u32x4*)(AH + (size_t)(st * 2 + 1) * DFF + ch), a1);
        float r0[8], r1[8];
#pragma unroll
        for (int e = 0; e < 8; ++e) {
            const float w0 = cw[ch + e], w1 = cw[DFF + ch + e], w2 = cw[2 * DFF + ch + e], bb = cb[ch + e];
            const float c0 = bb + w0 * gm2[e] + w1 * gm1[e] + w2 * g0[e], c1 = bb + w0 * gm1[e] + w1 * g0[e] + w2 * g1[e];
            r0[e] = c0 * sigmoidf_(c0) * a0[e]; r1[e] = c1 * sigmoidf_(c1) * a1[e];
        }
        u32x4 w; w.x = cvt_pk_bf16(r0[0], r0[1]); w.y = cvt_pk_bf16(r0[2], r0[3]); w.z = cvt_pk_bf16(r0[4], r0[5]); w.w = cvt_pk_bf16(r0[6], r0[7]);
        *(u32x4*)(ACT + (size_t)(st * 64) * DFF + ch) = w;
        w.x = cvt_pk_bf16(r1[0], r1[1]); w.y = cvt_pk_bf16(r1[2], r1[3]); w.z = cvt_pk_bf16(r1[4], r1[5]); w.w = cvt_pk_bf16(r1[6], r1[7]);
        *(u32x4*)(ACT + (size_t)(st * 64 + 1) * DFF + ch) = w;
    }
}

#define XB_TMO      128
#define XB_XCNT(j)  (256  + 64 * (j))
#define XB_XSUB(j)  (1280 + 64 * (j))
#define XB_XGEN(j)  (2304 + 64 * (j))
#define XB_TOP      3328
#define XB_TOPGEN   3392
#define XCD_BAR_WORDS 3456
#define XB_SPIN_CAP (1u << 18)

__device__ __forceinline__ unsigned xb_ld(unsigned* p)              { return __hip_atomic_load(p, __ATOMIC_RELAXED, __HIP_MEMORY_SCOPE_AGENT); }
__device__ __forceinline__ unsigned xb_add(unsigned* p, unsigned v) { return __hip_atomic_fetch_add(p, v, __ATOMIC_RELAXED, __HIP_MEMORY_SCOPE_AGENT); }
__device__ __forceinline__ unsigned xb_xcc_id() { return (unsigned)__builtin_amdgcn_s_getreg((3 << 11) | 20) & 0xFu; }
#define XB_SPIN(cond, bar) do { unsigned _sp = 0; while (cond) { __builtin_amdgcn_s_sleep(1); \
    if ((++_sp & 255u) == 0u) { if (xb_ld(&(bar)[XB_TMO])) break; if (_sp > XB_SPIN_CAP) { atomicAdd(&(bar)[XB_TMO], 1u); break; } } } } while (0)

struct XcdBarrier {
    unsigned* bar; unsigned x;
    volatile LAS unsigned* st;
};

__device__ __forceinline__ XcdBarrier xcd_barrier_post(unsigned* bar, volatile LAS unsigned* st) {
    XcdBarrier b; b.bar = bar; b.x = xb_xcc_id(); b.st = st;
    if (threadIdx.x == 0) (void)xb_add(&bar[XB_XCNT(b.x)], 1u);
    return b;
}
__device__ __forceinline__ void xcd_barrier_complete(unsigned* bar, unsigned x, unsigned& nloc, unsigned& nx) {
    const unsigned G = gridDim.x * gridDim.y * gridDim.z;
    unsigned sum, cnt, mine, sp = 0u;
    for (;;) {
        sum = 0u; cnt = 0u; mine = 0u;
#pragma unroll
        for (unsigned j = 0; j < 16; ++j) { const unsigned c = xb_ld(&bar[XB_XCNT(j)]); sum += c; cnt += (c > 0u) ? 1u : 0u; mine = (j == x) ? c : mine; }
        if (sum == G) break;
        __builtin_amdgcn_s_sleep(1);
        if ((++sp & 255u) == 0u) { if (xb_ld(&bar[XB_TMO])) break; if (sp > XB_SPIN_CAP) { atomicAdd(&bar[XB_TMO], 1u); break; } }
    }
    nloc = mine > 0u ? mine : 1u; nx = cnt > 0u ? cnt : 1u;
}

__device__ __forceinline__ void xcd_barrier(const XcdBarrier& b) {
    asm volatile("s_waitcnt vmcnt(0)" ::: "memory");
    __syncthreads();
    if (threadIdx.x == 0) {
        unsigned* bar = b.bar;
        __builtin_amdgcn_s_waitcnt(0);
        unsigned nloc = b.st[0], nx = b.st[1];
        if (nloc == 0u) { xcd_barrier_complete(bar, b.x, nloc, nx); b.st[0] = nloc; b.st[1] = nx; }
        const unsigned old = xb_add(&bar[XB_XSUB(b.x)], 1u);
        const unsigned gen = old / nloc;
        if (old + 1u == (gen + 1u) * nloc) {
            __builtin_amdgcn_fence(__ATOMIC_RELEASE, "agent");
            asm volatile("s_waitcnt vmcnt(0)" ::: "memory");
            const unsigned og = xb_add(&bar[XB_TOP], 1u);
            const unsigned tg = og / nx;
            if (og + 1u == (tg + 1u) * nx) xb_add(&bar[XB_TOPGEN], 1u);
            else XB_SPIN(xb_ld(&bar[XB_TOPGEN]) == tg, bar);
            __builtin_amdgcn_fence(__ATOMIC_ACQUIRE, "agent");
            xb_add(&bar[XB_XGEN(b.x)], 1u);
            asm volatile("s_waitcnt vmcnt(0)" ::: "memory");
        } else {
            XB_SPIN(xb_ld(&bar[XB_XGEN(b.x)]) == gen, bar);
            __builtin_amdgcn_fence(__ATOMIC_ACQUIRE, "agent");
            asm volatile("s_waitcnt vmcnt(0)" ::: "memory");
        }
    }
    __syncthreads();
}

#ifndef GEMM_SP2
#define GEMM_SP2 true
#endif
#ifndef GEMM_ALIGN_EPI
#define GEMM_ALIGN_EPI true
#endif
template <class Epi> __device__ __forceinline__ void run_gemm(LAS unsigned char* lds, const bf16_t* A, const bf16_t* Bt, int M, int N, int K, const Epi& E) {
    pg8::Gemm g{A, Bt, M, N, K}; pg8::StaticOrder So; So.init(M, N, (int)gridDim.x, (int)blockIdx.x);
    pg8::gemm_phase<Epi, pg8::StaticOrder, GEMM_ALIGN_EPI, GEMM_SP2>(lds, g, So, E);
}

__global__ void __launch_bounds__(512, 2) mega(Params p) {
    extern __shared__ __attribute__((aligned(16))) unsigned char shm[];
    LAS unsigned char* lds = (LAS unsigned char*)shm;
    cg::grid_group grid = cg::this_grid();
    unsigned char* ws = p.ws;
#ifndef PHMASK
#define PHMASK 0x7ff
#endif
#define IN(k) ((((PHMASK) >> (k)) & 1) && p.ph_lo <= (k) && (k) < p.ph_hi)
#define SEAM(k) do { if (IN(k) && IN((k) + 1)) xcd_barrier(xbar); } while (0)
    if (threadIdx.x < 4) ((volatile LAS unsigned*)(lds + LDS_XB))[threadIdx.x] = 0u;
    __syncthreads();
    if (IN(0)) phase0(p, lds);
    if (IN(0) && IN(1)) grid.sync();
    XcdBarrier xbar = xcd_barrier_post((unsigned*)(ws + WS_CTL + CTL_BAR), (volatile LAS unsigned*)(lds + LDS_XB));
    if (IN(1)) {
        run_gemm(lds, (const bf16_t*)(ws + WS_XB), (const bf16_t*)(ws + WS_WIN), S, PW, D, EpiBf16Plain{(bf16_t*)(ws + WS_P), PW});
        run_gemm(lds, (const bf16_t*)(ws + WS_WIN) + (size_t)PW * D, (const bf16_t*)(ws + WS_XB), 2048, S, D, EpiBf16PlainT<true>{(bf16_t*)(ws + WS_VT), S});
    }
    SEAM(1);
    if (IN(2)) ssm_pass<1>(p, lds);
    SEAM(2);
    if (IN(3)) {
#ifndef NO_ATT
        attn_phase(p, lds);
#endif
#ifndef NO_SSM2
        ssm_pass<2>(p, lds);
#endif
        __syncthreads(); }
    SEAM(3);
    if (IN(4)) run_gemm(lds, (const bf16_t*)(ws + WS_YG), (const bf16_t*)(ws + WS_WGLU), S, 2048, 2048, EpiGlu{(bf16_t*)(ws + WS_MIXA), D, (const bf16_t*)(ws + WS_YG), p.in[11]});
    SEAM(4);
    if (IN(5)) run_gemm(lds, (const bf16_t*)(ws + WS_MIXA), (const bf16_t*)(ws + WS_WOUT), S, D, D, EpiResX{(bf16_t*)(ws + WS_H1B), (const bf16_t*)(ws + WS_XB), D});
    SEAM(5);
    if (IN(6)) ln_rows<false>((bf16_t*)(ws + WS_H1B), nullptr, p.in[19], p.in[20]);
    SEAM(6);
    if (IN(7)) {
        run_gemm(lds, (const bf16_t*)(ws + WS_H1B), (const bf16_t*)(ws + WS_WUP), S, UPW, D, EpiConvGate{(bf16_t*)(ws + WS_ACT), (bf16_t*)(ws + WS_GH), (bf16_t*)(ws + WS_AH), p.in[22], p.in[23]});
        {
            const int nun = (S / 256) * (UPW / 256), G = (int)gridDim.x, rem = nun % G;
            const int sp0 = rem, nsp = G - rem;
            if ((int)blockIdx.x >= sp0) {
                const int wid = threadIdx.x >> 6, lane = threadIdx.x & 63;
                LAS float* scr = (LAS float*)(lds + wid * (64 * 65 * 4));
                constexpr int T_DN = (DFF / 64) * (D / 64);
                for (int it = ((int)blockIdx.x - sp0) * 8 + wid; it < T_DN; it += nsp * 8) transpose_tile_wide<0, true>(p.in[24], DFF, D, (bf16_t*)(ws + WS_WDOWN), scr, it, lane);
            }
        }
    }
    SEAM(7);
    if (IN(8)) conv_fix(p);
    SEAM(8);
    if (IN(9)) run_gemm(lds, (const bf16_t*)(ws + WS_ACT), (const bf16_t*)(ws + WS_WDOWN), S, D, DFF, EpiResB{(bf16_t*)(ws + WS_R1), (const bf16_t*)(ws + WS_H1B), D});
    SEAM(9);
    if (IN(10)) ln_rows<true>((bf16_t*)(ws + WS_R1), p.out, p.in[25], p.in[26]);
#undef IN
#undef SEAM
}
}

extern "C" void kernel_launch(void* const* d_in, const int* in_sizes, int n_in, void* d_out, int out_size, void* d_ws, size_t ws_size, hipStream_t stream) {
    static int grid = 0;
    if (grid == 0) {
        if (n_in != 27 || ws_size < mk::WS_END) { fprintf(stderr, "kernel_launch: unexpected inputs (n_in %d, ws %zu)\n", n_in, ws_size); grid = -1; return; }
        int dev = 0, cus = 0, per_cu = 0;
        (void)hipGetDevice(&dev); (void)hipDeviceGetAttribute(&cus, hipDeviceAttributeMultiprocessorCount, dev);
        if (hipFuncSetAttribute((const void*)mk::mega, hipFuncAttributeMaxDynamicSharedMemorySize, mk::LDS_BYTES) != hipSuccess) { fprintf(stderr, "kernel_launch: hipFuncSetAttribute failed\n"); grid = -1; return; }
        if (hipOccupancyMaxActiveBlocksPerMultiprocessor(&per_cu, (const void*)mk::mega, 512, mk::LDS_BYTES) != hipSuccess || per_cu < 1) { fprintf(stderr, "kernel_launch: occupancy query says %d\n", per_cu); per_cu = 1; }
        (void)hipGetLastError();
        grid = cus * 1;
        if (grid <= 0) grid = 256;
    }
    if (grid < 0) return;
    mk::Params p{};
    for (int i = 0; i < 27; ++i) p.in[i] = (const float*)d_in[i];
    p.out = (float*)d_out; p.ws = (unsigned char*)d_ws; p.ph_lo = 0; p.ph_hi = 11;
    void* args[] = {&p};
    const hipError_t e = hipLaunchCooperativeKernel((const void*)mk::mega, dim3(grid), dim3(512), args, mk::LDS_BYTES, stream);
    if (e != hipSuccess) fprintf(stderr, "kernel_launch: cooperative launch failed: %s (grid %d)\n", hipGetErrorString(e), grid);
}
```
